# Optimizing an MI355X kernel written in HIP

```python
import math
import jax
import jax.numpy as jnp
from jax import lax
import numpy as np

D_MODEL = 1024
BATCH = 8
SEQ = 2048
DEPTH = 4
DEC_BATCH = 128
DEC_SEQ = 1
PAST_LEN = 16384
PAGE_SIZE = 128

N_META = 16
NORM_EPS = 1e-6
CHUNK = 64
CONV_W = 4
N_BRANCH = 3

RW_HEADS = 8
RW_HD = 64
RW_W = RW_HEADS * RW_HD
RW_DECAY_LORA = 64
RW_AAA_LORA = 64
RW_SHIFT_W = 3 * RW_W + RW_DECAY_LORA + RW_AAA_LORA
RW_GN_EPS = 64e-5

SSM_HEADS = 8
SSM_HD = 64
SSM_W = SSM_HEADS * SSM_HD
SSM_STATE = 128
SSM_GROUPS = 2
SSM_CONV_CH = SSM_W + 2 * SSM_GROUPS * SSM_STATE

GDN_HEADS = 4
GDN_HD = 128
GDN_W = GDN_HEADS * GDN_HD
GDN_CONV_CH = 3 * GDN_W

OFF_RW = 0
OFF_RW_Z = OFF_RW + RW_SHIFT_W
OFF_SSM_Z = OFF_RW_Z + RW_W
OFF_SSM_XBC = OFF_SSM_Z + SSM_W
OFF_SSM_DT = OFF_SSM_XBC + SSM_CONV_CH
OFF_GDN_QKV = OFF_SSM_DT + SSM_HEADS
OFF_GDN_Z = OFF_GDN_QKV + GDN_CONV_CH
OFF_GDN_A = OFF_GDN_Z + GDN_W
OFF_GDN_B = OFF_GDN_A + GDN_HEADS
OFF_GATE = OFF_GDN_B + GDN_HEADS
D_IN_PROJ = OFF_GATE + N_BRANCH * D_MODEL

F32 = jnp.float32

kernel_name = 'hybrid_rwkv7_mamba2_gdn_decoder_step'


def rmsnorm(x, w, eps=NORM_EPS):
    xf = x.astype(F32)
    return xf * lax.rsqrt(jnp.mean(xf * xf, axis=-1, keepdims=True) + eps) * w.astype(F32)


def l2norm(x, eps=1e-6):
    return x * lax.rsqrt(jnp.sum(x * x, axis=-1, keepdims=True) + eps)


def chunk_len(L):
    return CHUNK if L % CHUNK == 0 else L


def causal_conv(u, buf, w):
    L = u.shape[1]
    full = jnp.concatenate([buf.astype(F32), u], axis=1)
    out = full[:, 0:L] * w[0]
    for i in range(1, CONV_W):
        out = out + full[:, i:i + L] * w[i]
    return out, full[:, L:]


def run_segments(fn, seqs, state, split):
    if split:
        y0, state = fn(*[s[:, :split] for s in seqs], state)
        y1, state = fn(*[s[:, split:] for s in seqs], state)
        return jnp.concatenate([y0, y1], axis=1), state
    return fn(*seqs, state)


def wkv7_scan(r, logw, k, v, a, b, s0):
    def step(S, inp):
        r_t, lw_t, k_t, v_t, a_t, b_t = inp
        sa = jnp.einsum('bhvk,bhk->bhv', S, a_t)
        S = (S * jnp.exp(lw_t)[:, :, None, :] + sa[..., None] * b_t[:, :, None, :]
             + v_t[..., None] * k_t[:, :, None, :])
        return S, jnp.einsum('bhvk,bhk->bhv', S, r_t)
    xs = tuple(jnp.moveaxis(t, 1, 0) for t in (r, logw, k, v, a, b))
    S, ys = lax.scan(step, s0, xs)
    return jnp.moveaxis(ys, 0, 1), S


def rwkv7_mix(p_rw, wkv0, prev0, mu, w0, w2, a0, a2, k_k, k_a, r_k, gn_w, gn_b):
    Bsz, L, _ = p_rw.shape
    shifted = jnp.concatenate([prev0.astype(F32)[:, None], p_rw[:, :-1]], axis=1)
    u = p_rw + (shifted - p_rw) * mu
    r = u[..., :RW_W]
    k = u[..., RW_W:2 * RW_W]
    v = u[..., 2 * RW_W:3 * RW_W]
    wd = u[..., 3 * RW_W:3 * RW_W + RW_DECAY_LORA]
    ad = u[..., 3 * RW_W + RW_DECAY_LORA:]
    w = -jax.nn.softplus(-(w0 + jnp.tanh(wd) @ w2)) - 0.5
    log_decay = -jnp.exp(w)
    a = jax.nn.sigmoid(a0 + ad @ a2)
    hs = lambda t: t.reshape(Bsz, L, RW_HEADS, RW_HD)
    kk = l2norm(hs(k * k_k))
    k = k * (1.0 + (a - 1.0) * k_a)
    r, k, v, a, log_decay = (hs(t) for t in (r, k, v, a, log_decay))
    y, wkv1 = wkv7_scan(r, log_decay, k, v, -kk, kk * a, wkv0.astype(F32))
    mean = jnp.mean(y, axis=-1, keepdims=True)
    var = jnp.mean(jnp.square(y - mean), axis=-1, keepdims=True)
    y = ((y - mean) * lax.rsqrt(var + RW_GN_EPS)).reshape(Bsz, L, RW_W) * gn_w + gn_b
    bonus = jnp.sum(r * k * r_k, axis=-1, keepdims=True) * v
    return y + bonus.reshape(Bsz, L, RW_W), wkv1, p_rw[:, -1]


def ssd_chunked(x, dt, a, bm, cm, h0):
    Bsz, L, H, P = x.shape
    R = H // SSM_GROUPS
    c = chunk_len(L)
    n = L // c
    x = x.reshape(Bsz, n, c, SSM_GROUPS, R, P)
    dt = dt.reshape(Bsz, n, c, SSM_GROUPS, R)
    bm = bm.reshape(Bsz, n, c, SSM_GROUPS, SSM_STATE)
    cm = cm.reshape(Bsz, n, c, SSM_GROUPS, SSM_STATE)
    acs = jnp.cumsum(dt * a.reshape(SSM_GROUPS, R), axis=2)
    xdt = x * dt[..., None]
    acs_t = jnp.moveaxis(acs, 2, -1)
    tri = jnp.tril(jnp.ones((c, c), dtype=bool))
    seg = jnp.exp(jnp.where(tri, acs_t[..., :, None] - acs_t[..., None, :], -jnp.inf))
    cb = jnp.einsum('bnigs,bnjgs->bngij', cm, bm)
    y_diag = jnp.einsum('bngrij,bnjgrp->bnigrp', cb[:, :, :, None] * seg, xdt)
    decay_end = jnp.exp(acs[:, :, -1:] - acs)
    st = jnp.einsum('bncgs,bncgr,bncgrp->bngrps', bm, decay_end, xdt)
    tot = jnp.exp(acs[:, :, -1])

    def step(h, inp):
        t, s = inp
        return h * t[..., None, None] + s, h
    hN, h_prev = lax.scan(step, h0.reshape(Bsz, SSM_GROUPS, R, P, SSM_STATE),
                          (jnp.moveaxis(tot, 1, 0), jnp.moveaxis(st, 1, 0)))
    h_prev = jnp.moveaxis(h_prev, 0, 1)
    y_off = jnp.einsum('bnigs,bngrps,bnigr->bnigrp', cm, h_prev, jnp.exp(acs))
    return (y_diag + y_off).reshape(Bsz, L, H, P), hN.reshape(Bsz, H, P, SSM_STATE)


def mamba2_mix(xbc_pre, dt_raw, z, ssm0, conv0, conv_w, conv_b, dt_bias, a_log, d_skip, norm_w, split):
    Bsz, L, _ = xbc_pre.shape
    xbc, conv1 = causal_conv(xbc_pre, conv0, conv_w)
    xbc = jax.nn.silu(xbc + conv_b)
    xs = xbc[..., :SSM_W].reshape(Bsz, L, SSM_HEADS, SSM_HD)
    bm = xbc[..., SSM_W:SSM_W + SSM_GROUPS * SSM_STATE].reshape(Bsz, L, SSM_GROUPS, SSM_STATE)
    cm = xbc[..., SSM_W + SSM_GROUPS * SSM_STATE:].reshape(Bsz, L, SSM_GROUPS, SSM_STATE)
    dt = jax.nn.softplus(dt_raw + dt_bias)
    a = -jnp.exp(a_log.astype(F32))
    y, ssm1 = run_segments(lambda x_, dt_, b_, c_, h_: ssd_chunked(x_, dt_, a, b_, c_, h_),
                           (xs, dt, bm, cm), ssm0.astype(F32), split)
    y = (y + xs * d_skip[:, None]).reshape(Bsz, L, SSM_W)
    g = (y * jax.nn.silu(z)).reshape(Bsz, L, SSM_GROUPS, SSM_W // SSM_GROUPS)
    g = g * lax.rsqrt(jnp.mean(g * g, axis=-1, keepdims=True) + 1e-5)
    return g.reshape(Bsz, L, SSM_W) * norm_w, ssm1, conv1


def gdn_chunked(q, k, v, g, beta, s0):
    Bsz, L, H, D = q.shape
    c = chunk_len(L)
    n = L // c
    blk = lambda t: t.reshape(Bsz, n, c, H, D).transpose(0, 3, 1, 2, 4)
    q, k, v = blk(q), blk(k), blk(v)
    g = g.reshape(Bsz, n, c, H).transpose(0, 3, 1, 2)
    beta = beta.reshape(Bsz, n, c, H).transpose(0, 3, 1, 2)
    gcs = jnp.cumsum(g, axis=-1)
    idx = jnp.arange(c)
    incl = idx[:, None] >= idx[None, :]
    strict = idx[:, None] > idx[None, :]
    decay = jnp.exp(jnp.where(incl, gcs[..., :, None] - gcs[..., None, :], -jnp.inf))
    kb = k * beta[..., None]
    a_mat = jnp.where(strict, jnp.einsum('bhnid,bhnjd->bhnij', kb, k) * decay, 0.0)
    rhs = jnp.concatenate([v * beta[..., None], kb * jnp.exp(gcs)[..., None]], axis=-1)
    sol = lax.linalg.triangular_solve(a_mat, rhs, left_side=True, lower=True, unit_diagonal=True)
    u, w_cum = sol[..., :D], sol[..., D:]
    qk = jnp.where(incl, jnp.einsum('bhnid,bhnjd->bhnij', q, k) * decay, 0.0)
    q_dec = q * jnp.exp(gcs)[..., None]
    k_dec = k * jnp.exp(gcs[..., -1:] - gcs)[..., None]
    g_tot = jnp.exp(gcs[..., -1])

    def step(S, inp):
        u_c, w_c, qd_c, qk_c, kd_c, gt_c = inp
        v_new = u_c - jnp.einsum('bhck,bhkv->bhcv', w_c, S)
        o_c = jnp.einsum('bhck,bhkv->bhcv', qd_c, S) + jnp.einsum('bhij,bhjv->bhiv', qk_c, v_new)
        S = S * gt_c[..., None, None] + jnp.einsum('bhck,bhcv->bhkv', kd_c, v_new)
        return S, o_c
    xs = tuple(jnp.moveaxis(t, 2, 0) for t in (u, w_cum, q_dec, qk, k_dec, g_tot))
    S, o = lax.scan(step, s0, xs)
    return o.transpose(1, 0, 3, 2, 4).reshape(Bsz, L, H, D), S


def gdn_mix(qkv_pre, a_raw, b_raw, z, gdn0, conv0, conv_w, dt_bias, a_log, norm_w, split):
    Bsz, L, _ = qkv_pre.shape
    qkv, conv1 = causal_conv(qkv_pre, conv0, conv_w)
    qkv = jax.nn.silu(qkv)
    hs = lambda t: t.reshape(Bsz, L, GDN_HEADS, GDN_HD)
    q = l2norm(hs(qkv[..., :GDN_W])) * (GDN_HD ** -0.5)
    k = l2norm(hs(qkv[..., GDN_W:2 * GDN_W]))
    v = hs(qkv[..., 2 * GDN_W:])
    g = -jnp.exp(a_log.astype(F32)) * jax.nn.softplus(a_raw + dt_bias)
    beta = jax.nn.sigmoid(b_raw)
    o, gdn1 = run_segments(gdn_chunked, (q, k, v, g, beta), gdn0.astype(F32), split)
    o = o * lax.rsqrt(jnp.mean(o * o, axis=-1, keepdims=True) + 1e-6) * norm_w
    return o.reshape(Bsz, L, GDN_W) * jax.nn.silu(z), gdn1, conv1


def mixer_layer(x, st, p, split):
    wkv0, prev0, ssm0, sconv0, gdn0, gconv0 = st
    Bsz, T, _ = x.shape
    h = rmsnorm(x, p['norm_w'])
    proj = h @ p['w_in']
    rw, wkv1, prev1 = rwkv7_mix(proj[..., OFF_RW:OFF_RW + RW_SHIFT_W], wkv0, prev0, p['rw_mu'],
                                p['rw_w0'], p['rw_w2'], p['rw_a0'], p['rw_a2'], p['rw_k_k'],
                                p['rw_k_a'], p['rw_r_k'], p['rw_gn_w'], p['rw_gn_b'])
    rw = rw * jax.nn.silu(proj[..., OFF_RW_Z:OFF_RW_Z + RW_W])
    sm, ssm1, sconv1 = mamba2_mix(proj[..., OFF_SSM_XBC:OFF_SSM_XBC + SSM_CONV_CH],
                                  proj[..., OFF_SSM_DT:OFF_SSM_DT + SSM_HEADS],
                                  proj[..., OFF_SSM_Z:OFF_SSM_Z + SSM_W], ssm0, sconv0,
                                  p['ssm_conv_w'], p['ssm_conv_b'], p['ssm_dt_bias'],
                                  p['ssm_a_log'], p['ssm_d'], p['ssm_norm_w'], split)
    gd, gdn1, gconv1 = gdn_mix(proj[..., OFF_GDN_QKV:OFF_GDN_QKV + GDN_CONV_CH],
                               proj[..., OFF_GDN_A:OFF_GDN_A + GDN_HEADS],
                               proj[..., OFF_GDN_B:OFF_GDN_B + GDN_HEADS],
                               proj[..., OFF_GDN_Z:OFF_GDN_Z + GDN_W], gdn0, gconv0,
                               p['gdn_conv_w'], p['gdn_dt_bias'], p['gdn_a_log'],
                               p['gdn_norm_w'], split)
    gates = jax.nn.sigmoid(proj[..., OFF_GATE:].reshape(Bsz, T, N_BRANCH, D_MODEL))
    merged = (gates[..., 0, :] * (rw @ p['w_rw_out'])
              + gates[..., 1, :] * (sm @ p['w_ssm_out'])
              + gates[..., 2, :] * (gd @ p['w_gdn_out']))
    x = x + (merged @ p['w_out']).astype(x.dtype)
    new_st = (wkv1.astype(wkv0.dtype), prev1.astype(prev0.dtype), ssm1.astype(ssm0.dtype),
              sconv1.astype(sconv0.dtype), gdn1.astype(gdn0.dtype), gconv1.astype(gconv0.dtype))
    return x, new_st


def trunk(x, states, layer_params, final_norm_w, split):
    new_states = [[] for _ in states]
    for l in range(DEPTH):
        p = {name: arr[l] for name, arr in layer_params.items()}
        x, st = mixer_layer(x, tuple(s[l] for s in states), p, split)
        for acc, s in zip(new_states, st):
            acc.append(s)
    y = rmsnorm(x, final_norm_w).astype(x.dtype)
    return y, tuple(jnp.stack(acc) for acc in new_states)


def setup_inputs(seed: int = 0) -> dict:
    key = jax.random.key(seed)
    keys = iter(jax.random.split(key, 40))

    def nrm(shape, scale):
        return jax.random.normal(next(keys), shape, F32) * scale

    def unif(shape, lo, hi):
        return jax.random.uniform(next(keys), shape, F32, lo, hi)

    def gain(shape):
        return 1.0 + nrm(shape, 0.02)

    def dt_bias(shape):
        dt = jnp.exp(unif(shape, math.log(1e-3), math.log(1e-1)))
        return dt + jnp.log(-jnp.expm1(-dt))

    return {
        'x_prompt': nrm((BATCH, SEQ, D_MODEL), 1.0),
        'x_sample': nrm((DEC_BATCH, DEC_SEQ, D_MODEL), 1.0),
        'state_rwkv_wkv': nrm((DEPTH, DEC_BATCH, RW_HEADS, RW_HD, RW_HD), 0.3),
        'state_rwkv_shift': nrm((DEPTH, DEC_BATCH, RW_SHIFT_W), 1.0),
        'state_ssm': nrm((DEPTH, DEC_BATCH, SSM_HEADS, SSM_HD, SSM_STATE), 0.3),
        'state_ssm_conv': nrm((DEPTH, DEC_BATCH, CONV_W - 1, SSM_CONV_CH), 1.0),
        'state_gdn': nrm((DEPTH, DEC_BATCH, GDN_HEADS, GDN_HD, GDN_HD), 0.1),
        'state_gdn_conv': nrm((DEPTH, DEC_BATCH, CONV_W - 1, GDN_CONV_CH), 1.0),
        'meta_tokens': nrm((N_META, D_MODEL), 1.0),
        'norm_w': gain((DEPTH, D_MODEL)),
        'w_in': nrm((DEPTH, D_MODEL, D_IN_PROJ), D_MODEL ** -0.5),
        'rw_mu': unif((DEPTH, RW_SHIFT_W), 0.0, 1.0),
        'rw_w0': unif((DEPTH, RW_W), -6.0, 1.0),
        'rw_w2': nrm((DEPTH, RW_DECAY_LORA, RW_W), 0.1 * RW_DECAY_LORA ** -0.5),
        'rw_a0': nrm((DEPTH, RW_W), 0.1),
        'rw_a2': nrm((DEPTH, RW_AAA_LORA, RW_W), RW_AAA_LORA ** -0.5),
        'rw_k_k': 0.85 + nrm((DEPTH, RW_W), 0.02),
        'rw_k_a': gain((DEPTH, RW_W)),
        'rw_r_k': nrm((DEPTH, RW_HEADS, RW_HD), 0.1),
        'rw_gn_w': gain((DEPTH, RW_W)),
        'rw_gn_b': nrm((DEPTH, RW_W), 0.02),
        'ssm_conv_w': nrm((DEPTH, CONV_W, SSM_CONV_CH), CONV_W ** -0.5),
        'ssm_conv_b': nrm((DEPTH, SSM_CONV_CH), 0.02),
        'ssm_dt_bias': dt_bias((DEPTH, SSM_HEADS)),
        'ssm_a_log': jnp.log(unif((DEPTH, SSM_HEADS), 1.0, 16.0)),
        'ssm_d': 1.0 + nrm((DEPTH, SSM_HEADS), 0.1),
        'ssm_norm_w': gain((DEPTH, SSM_W)),
        'gdn_conv_w': nrm((DEPTH, CONV_W, GDN_CONV_CH), CONV_W ** -0.5),
        'gdn_dt_bias': dt_bias((DEPTH, GDN_HEADS)),
        'gdn_a_log': jnp.log(unif((DEPTH, GDN_HEADS), 1.0, 16.0)),
        'gdn_norm_w': gain((DEPTH, GDN_HD)),
        'w_rw_out': nrm((DEPTH, RW_W, D_MODEL), RW_W ** -0.5),
        'w_ssm_out': nrm((DEPTH, SSM_W, D_MODEL), SSM_W ** -0.5),
        'w_gdn_out': nrm((DEPTH, GDN_W, D_MODEL), GDN_W ** -0.5),
        'w_out': nrm((DEPTH, D_MODEL, D_MODEL), D_MODEL ** -0.5),
        'final_norm_w': gain((D_MODEL,)),
    }


def reference(x_prompt, x_sample, state_rwkv_wkv, state_rwkv_shift, state_ssm, state_ssm_conv,
              state_gdn, state_gdn_conv, meta_tokens, norm_w, w_in, rw_mu, rw_w0, rw_w2, rw_a0,
              rw_a2, rw_k_k, rw_k_a, rw_r_k, rw_gn_w, rw_gn_b, ssm_conv_w, ssm_conv_b,
              ssm_dt_bias, ssm_a_log, ssm_d, ssm_norm_w, gdn_conv_w, gdn_dt_bias, gdn_a_log,
              gdn_norm_w, w_rw_out, w_ssm_out, w_gdn_out, w_out, final_norm_w):
    layer_params = {
        'norm_w': norm_w, 'w_in': w_in, 'rw_mu': rw_mu, 'rw_w0': rw_w0, 'rw_w2': rw_w2,
        'rw_a0': rw_a0, 'rw_a2': rw_a2, 'rw_k_k': rw_k_k, 'rw_k_a': rw_k_a, 'rw_r_k': rw_r_k,
        'rw_gn_w': rw_gn_w, 'rw_gn_b': rw_gn_b, 'ssm_conv_w': ssm_conv_w,
        'ssm_conv_b': ssm_conv_b, 'ssm_dt_bias': ssm_dt_bias, 'ssm_a_log': ssm_a_log,
        'ssm_d': ssm_d, 'ssm_norm_w': ssm_norm_w, 'gdn_conv_w': gdn_conv_w,
        'gdn_dt_bias': gdn_dt_bias, 'gdn_a_log': gdn_a_log, 'gdn_norm_w': gdn_norm_w,
        'w_rw_out': w_rw_out, 'w_ssm_out': w_ssm_out, 'w_gdn_out': w_gdn_out, 'w_out': w_out,
    }
    sample_states = (state_rwkv_wkv, state_rwkv_shift, state_ssm, state_ssm_conv,
                     state_gdn, state_gdn_conv)
    bp = x_prompt.shape[0]
    prompt_states = tuple(jnp.zeros((DEPTH, bp) + s.shape[2:], x_prompt.dtype) for s in sample_states)
    meta = jnp.broadcast_to(meta_tokens.astype(x_prompt.dtype)[None], (bp, N_META, D_MODEL))
    x_full = jnp.concatenate([meta, x_prompt], axis=1)
    y_full, (p_wkv, p_shift, p_ssm, p_ssm_conv, p_gdn, p_gdn_conv) = trunk(
        x_full, prompt_states, layer_params, final_norm_w, N_META)
    y_prompt = y_full[:, N_META:]
    y_sample, (s_wkv, s_shift, s_ssm, s_ssm_conv, s_gdn, s_gdn_conv) = trunk(
        x_sample, sample_states, layer_params, final_norm_w, 0)
    return (y_prompt, y_sample, p_wkv, p_shift, p_ssm, p_ssm_conv, p_gdn, p_gdn_conv,
            s_wkv, s_shift, s_ssm, s_ssm_conv, s_gdn, s_gdn_conv)
```

```cpp
#include <hip/hip_runtime.h>
#include <hip/hip_cooperative_groups.h>
#include <cstdio>
namespace cg = cooperative_groups;

#ifndef MULTI_LAUNCH
#define MULTI_LAUNCH 0
#endif

typedef unsigned short bf16_t;
using bf16x8 = __attribute__((ext_vector_type(8))) short;
using f32x4 = __attribute__((ext_vector_type(4))) float;
using u32x4 = __attribute__((ext_vector_type(4))) unsigned;

constexpr int DM = 1024;
constexpr int LP = 2064;
constexpr int NTP = 8 * LP;
constexpr int NT = NTP + 128;
constexpr int DEPTH = 4;
constexpr int DPROJ = 8848;
constexpr int PRE_W = 4352;
constexpr int POST_W = 4608;
constexpr int NPAD = PRE_W + POST_W;
constexpr int PC_RW = 0, PC_XBC = 1664, PC_QKV = 2688, PC_DT = 4224, PC_GA = 4232, PC_GB = 4236;
constexpr int QC_RWZ = 0, QC_SSMZ = 512, QC_GDNZ = 1024, QC_GATE = 1536;

constexpr size_t SZ_X = (size_t)NT * 1024 * 4;
constexpr size_t SZ_PRE = (size_t)NT * PRE_W * 2;
constexpr size_t SZ_POST = (size_t)NT * POST_W * 2;
constexpr size_t OFF_X = 0;
constexpr size_t OFF_PRE = OFF_X + SZ_X;
constexpr size_t OFF_POST = OFF_PRE + SZ_PRE;
constexpr size_t OFF_SCAN = OFF_POST + SZ_POST;
constexpr size_t OFF_RWW = OFF_SCAN;
constexpr size_t OFF_RW5 = OFF_RWW + (size_t)NT * 512 * 4;
constexpr size_t OFF_RWSC = OFF_RW5 + (size_t)NT * 5 * 512 * 2;
constexpr size_t OFF_SXBC = OFF_RWSC + (size_t)NT * 32 * 4;
constexpr size_t OFF_SDT = OFF_SXBC + (size_t)NT * 1024 * 2;
constexpr size_t OFF_GQKV = OFF_SDT + (size_t)NT * 16 * 4;
constexpr size_t OFF_GSC = OFF_GQKV + (size_t)NT * 1536 * 2;
constexpr size_t OFF_STAT = OFF_GSC + (size_t)NT * 16 * 4;
constexpr size_t OFF_WIN = OFF_STAT + (size_t)NT * 32 * 4;
constexpr size_t OFF_WBR = OFF_WIN + (size_t)NPAD * 1024 * 2;
constexpr size_t OFF_WOUT = OFF_WBR + (size_t)3 * 1024 * 512 * 2;
constexpr size_t OFF_W2T = OFF_WOUT + (size_t)1024 * 1024 * 2;
constexpr size_t OFF_A2T = OFF_W2T + (size_t)512 * 64 * 2;
constexpr size_t OFF_BAR = OFF_A2T + (size_t)512 * 64 * 2;
constexpr size_t BAR_BYTES = 3456 * 4;
constexpr size_t WS_NEED = OFF_BAR + 16384;
constexpr size_t OFF_H = OFF_SCAN;
constexpr size_t OFF_BR = OFF_PRE;
constexpr size_t OFF_MERGED = OFF_PRE + (size_t)NT * 1536 * 2;

constexpr size_t O_YP = 0;
constexpr size_t O_YS = O_YP + (size_t)8 * 2048 * 1024;
constexpr size_t O_P_WKV = O_YS + (size_t)128 * 1024;
constexpr size_t O_P_SHIFT = O_P_WKV + (size_t)4 * 8 * 8 * 64 * 64;
constexpr size_t O_P_SSM = O_P_SHIFT + (size_t)4 * 8 * 1664;
constexpr size_t O_P_SCONV = O_P_SSM + (size_t)4 * 8 * 8 * 64 * 128;
constexpr size_t O_P_GDN = O_P_SCONV + (size_t)4 * 8 * 3 * 1024;
constexpr size_t O_P_GCONV = O_P_GDN + (size_t)4 * 8 * 4 * 128 * 128;
constexpr size_t O_S_WKV = O_P_GCONV + (size_t)4 * 8 * 3 * 1536;
constexpr size_t O_S_SHIFT = O_S_WKV + (size_t)4 * 128 * 8 * 64 * 64;
constexpr size_t O_S_SSM = O_S_SHIFT + (size_t)4 * 128 * 1664;
constexpr size_t O_S_SCONV = O_S_SSM + (size_t)4 * 128 * 8 * 64 * 128;
constexpr size_t O_S_GDN = O_S_SCONV + (size_t)4 * 128 * 3 * 1024;
constexpr size_t O_S_GCONV = O_S_GDN + (size_t)4 * 128 * 4 * 128 * 128;
constexpr size_t O_TOTAL = O_S_GCONV + (size_t)4 * 128 * 3 * 1536;

constexpr int SMEM_BYTES = 73728;
constexpr int LDS_STRIDE = 64;

struct Params {
  const float* in[36];
  float* out;
  char* ws;
};

__device__ __forceinline__ bf16_t f2bf(float f) {
  unsigned u = __float_as_uint(f);
  u += 0x7fffu + ((u >> 16) & 1u);
  return (bf16_t)(u >> 16);
}
__device__ __forceinline__ float bf2f(bf16_t h) { return __uint_as_float(((unsigned)h) << 16); }
__device__ __forceinline__ unsigned pack2(float a, float b) { return (unsigned)f2bf(a) | ((unsigned)f2bf(b) << 16); }
__device__ __forceinline__ float bflo(unsigned u) { return __uint_as_float(u << 16); }
__device__ __forceinline__ float bfhi(unsigned u) { return __uint_as_float(u & 0xffff0000u); }
__device__ __forceinline__ float rbf(float f) { return bf2f(f2bf(f)); }

__device__ __forceinline__ int otid() { int t = threadIdx.x; asm volatile("" : "+v"(t)); return t; }
template <int CTRL>
__device__ __forceinline__ float dppf(float v) {
  return __int_as_float(__builtin_amdgcn_update_dpp(0, __float_as_int(v), CTRL, 0xF, 0xF, true));
}
__device__ __forceinline__ float red4(float v) { v += dppf<0xB1>(v); v += dppf<0x4E>(v); return v; }
__device__ __forceinline__ float red8(float v) { v = red4(v); v += dppf<0x141>(v); return v; }
__device__ __forceinline__ float red16(float v) { v = red8(v); v += dppf<0x140>(v); return v; }
__device__ __forceinline__ float wave_sum(float v) {
  v = red16(v);
  const int iv = __float_as_int(v);
  const float r0 = __int_as_float(__builtin_amdgcn_readlane(iv, 0));
  const float r1 = __int_as_float(__builtin_amdgcn_readlane(iv, 16));
  const float r2 = __int_as_float(__builtin_amdgcn_readlane(iv, 32));
  const float r3 = __int_as_float(__builtin_amdgcn_readlane(iv, 48));
  return (r0 + r1) + (r2 + r3);
}
__device__ __forceinline__ float frcp_(float x) { return __builtin_amdgcn_rcpf(x); }
__device__ __forceinline__ float sigmoidf_(float x) { return frcp_(1.f + __expf(-x)); }
__device__ __forceinline__ float siluf_(float x) { return x * frcp_(1.f + __expf(-x)); }
__device__ __forceinline__ float softplusf_(float x) { return fmaxf(x, 0.f) + __logf(1.f + __expf(-fabsf(x))); }
__device__ __forceinline__ float ftanh_(float x) {
  const float e = __expf(-2.f * fabsf(x));
  const float t = (1.f - e) * frcp_(1.f + e);
  return x < 0.f ? -t : t;
}

__device__ __forceinline__ void row_to_seq(int row, int& seq, int& t) {
  if (row < NTP) { seq = row / LP; t = row - seq * LP; } else { seq = 8 + (row - NTP); t = 0; }
}

__device__ __forceinline__ bool tile_at(int it, int MT, int NTn, int& mt, int& nt) {
  const int G = gridDim.x;
  const int nx = (G % 8 == 0) ? 8 : 1;
  const int x = blockIdx.x % nx, j = blockIdx.x / nx, nloc = G / nx;
  const int ch = x + nx * it;
  const int q = ch * nloc + j;
  if (q >= MT * NTn) return false;
  const int gs = 8 * NTn;
  const int g = q / gs, rem = q - g * gs;
  const int gsz = min(8, MT - g * 8);
  nt = rem / gsz;
  mt = g * 8 + (rem - nt * gsz);
  return true;
}
__device__ __forceinline__ int tile_iters(int MT, int NTn) {
  const int G = gridDim.x;
  const int nx = (G % 8 == 0) ? 8 : 1;
  const int nloc = G / nx;
  const int nchunks = (MT * NTn + nloc - 1) / nloc;
  return (nchunks + nx - 1) / nx;
}

__device__ __forceinline__ void mma_ktile(const bf16_t* cA, const bf16_t* cB, int fo0, int fo1, f32x4 (&acc)[4][4]) {
#pragma unroll
  for (int ks = 0; ks < 2; ++ks) {
    const int fo = ks ? fo1 : fo0;
    bf16x8 af[4], bfr[4];
#pragma unroll
    for (int i = 0; i < 4; ++i) af[i] = *(const bf16x8*)(cA + i * 16 * LDS_STRIDE + fo);
#pragma unroll
    for (int j = 0; j < 4; ++j) bfr[j] = *(const bf16x8*)(cB + j * 16 * LDS_STRIDE + fo);
#pragma unroll
    for (int i = 0; i < 4; ++i)
#pragma unroll
      for (int j = 0; j < 4; ++j)
        acc[i][j] = __builtin_amdgcn_mfma_f32_16x16x32_bf16(bfr[j], af[i], acc[i][j], 0, 0, 0);
  }
}

template <bool DEEP>
__device__ __forceinline__ void gemm_core(const bf16_t* __restrict__ A, int lda, const bf16_t* __restrict__ Bt, int ldb,
                                          int K, f32x4 (&acc)[4][4], char* smem) {
  bf16_t* sA = (bf16_t*)smem;
  bf16_t* sB = sA + 2 * 128 * LDS_STRIDE;
  const int tid = otid(), lane = tid & 63, wave = tid >> 6;
  const int wm = wave >> 1, wn = wave & 1;
  const int lr = tid >> 3, lc = (tid & 7) * 8;
  const bf16_t* ap = A + (size_t)lr * lda + lc;
  const bf16_t* bp = Bt + (size_t)lr * ldb + lc;
  const int nk = K >> 6;
  const int fr = lane & 15, fq = (lane >> 4) * 8;
  const int rswz = (fr >> 1) & 7, wswz = (lr >> 1) & 7;
  const int fo0 = (((lane >> 4)) ^ rswz) * 8, fo1 = ((4 + (lane >> 4)) ^ rswz) * 8;
  const bf16_t* cA0 = sA + (wm * 64 + fr) * LDS_STRIDE;
  const bf16_t* cB0 = sB + (wn * 64 + fr) * LDS_STRIDE;
  bf16_t* wA = sA + lr * LDS_STRIDE + (((tid & 7) ^ wswz) * 8);
  bf16_t* wB = sB + lr * LDS_STRIDE + (((tid & 7) ^ wswz) * 8);
  constexpr int BUF = 128 * LDS_STRIDE;
#define GLOAD(RA, RB, kt_)                                                         \
  _Pragma("unroll") for (int i = 0; i < 4; ++i) {                                  \
    RA[i] = *(const u32x4*)(ap + (size_t)(32 * i) * lda + ((kt_) << 6));           \
    RB[i] = *(const u32x4*)(bp + (size_t)(32 * i) * ldb + ((kt_) << 6));           \
  }
#define SWRITE(RA, RB, buf_)                                                       \
  _Pragma("unroll") for (int i = 0; i < 4; ++i) {                                  \
    *(u32x4*)(wA + (buf_) * BUF + 32 * i * LDS_STRIDE) = RA[i];                    \
    *(u32x4*)(wB + (buf_) * BUF + 32 * i * LDS_STRIDE) = RB[i];                    \
  }
  u32x4 ra0[4], rb0[4];
  GLOAD(ra0, rb0, 0);
  if (DEEP) {
    u32x4 ra1[4], rb1[4];
    GLOAD(ra1, rb1, 1);
    __syncthreads();
    SWRITE(ra0, rb0, 0);
    __syncthreads();
    for (int kt = 0; kt < nk; kt += 2) {
      { const int k2 = min(kt + 2, nk - 1); GLOAD(ra0, rb0, k2); }
      mma_ktile(cA0, cB0, fo0, fo1, acc);
      SWRITE(ra1, rb1, 1);
      __syncthreads();
      { const int k3 = min(kt + 3, nk - 1); GLOAD(ra1, rb1, k3); }
      mma_ktile(cA0 + BUF, cB0 + BUF, fo0, fo1, acc);
      if (kt + 2 < nk) { SWRITE(ra0, rb0, 0); }
      __syncthreads();
    }
  } else {
    __syncthreads();
    SWRITE(ra0, rb0, 0);
    __syncthreads();
    for (int kt = 0; kt < nk; ++kt) {
      const int cur = kt & 1;
      { const int k1 = min(kt + 1, nk - 1); GLOAD(ra0, rb0, k1); }
      mma_ktile(cA0 + cur * BUF, cB0 + cur * BUF, fo0, fo1, acc);
      if (kt + 1 < nk) { SWRITE(ra0, rb0, cur ^ 1); }
      __syncthreads();
    }
  }
#undef GLOAD
#undef SWRITE
}

__device__ __forceinline__ void gemm_core_big(const bf16_t* __restrict__ A, int lda, const bf16_t* __restrict__ Bt, int ldb,
                                              int K, f32x4 (&acc)[8][4], char* smem) {
  bf16_t* sA = (bf16_t*)smem;
  bf16_t* sB = sA + 256 * LDS_STRIDE;
  const int tid = otid(), lane = tid & 63, wave = tid >> 6;
  const int wm = wave >> 1, wn = wave & 1;
  const int lr = tid >> 3, lc = (tid & 7) * 8;
  const bf16_t* ap = A + (size_t)lr * lda + lc;
  const bf16_t* bp = Bt + (size_t)lr * ldb + lc;
  const int nk = K >> 6;
  const int fr = lane & 15, fq = (lane >> 4) * 8;
  const int rswz = (fr >> 1) & 7, wswz = (lr >> 1) & 7;
  const int fo0 = (((lane >> 4)) ^ rswz) * 8, fo1 = ((4 + (lane >> 4)) ^ rswz) * 8;
  const bf16_t* cA = sA + (wm * 128 + fr) * LDS_STRIDE;
  const bf16_t* cB = sB + (wn * 64 + fr) * LDS_STRIDE;
  bf16_t* wA = sA + lr * LDS_STRIDE + (((tid & 7) ^ wswz) * 8);
  bf16_t* wB = sB + lr * LDS_STRIDE + (((tid & 7) ^ wswz) * 8);
  u32x4 ra[8], rb[4];
#pragma unroll
  for (int i = 0; i < 8; ++i) ra[i] = *(const u32x4*)(ap + (size_t)(32 * i) * lda);
#pragma unroll
  for (int i = 0; i < 4; ++i) rb[i] = *(const u32x4*)(bp + (size_t)(32 * i) * ldb);
  for (int kt = 0; kt < nk; ++kt) {
    __syncthreads();
#pragma unroll
    for (int i = 0; i < 8; ++i) *(u32x4*)(wA + 32 * i * LDS_STRIDE) = ra[i];
#pragma unroll
    for (int i = 0; i < 4; ++i) *(u32x4*)(wB + 32 * i * LDS_STRIDE) = rb[i];
    __syncthreads();
    {
      const int k1 = min(kt + 1, nk - 1) << 6;
#pragma unroll
      for (int i = 0; i < 8; ++i) ra[i] = *(const u32x4*)(ap + (size_t)(32 * i) * lda + k1);
#pragma unroll
      for (int i = 0; i < 4; ++i) rb[i] = *(const u32x4*)(bp + (size_t)(32 * i) * ldb + k1);
    }
#pragma unroll
    for (int ks = 0; ks < 2; ++ks) {
      const int fo = ks ? fo1 : fo0;
      bf16x8 bfr[4];
#pragma unroll
      for (int j = 0; j < 4; ++j) bfr[j] = *(const bf16x8*)(cB + j * 16 * LDS_STRIDE + fo);
#pragma unroll
      for (int i = 0; i < 8; ++i) {
        const bf16x8 af = *(const bf16x8*)(cA + i * 16 * LDS_STRIDE + fo);
#pragma unroll
        for (int j = 0; j < 4; ++j)
          acc[i][j] = __builtin_amdgcn_mfma_f32_16x16x32_bf16(bfr[j], af, acc[i][j], 0, 0, 0);
      }
    }
  }
}

__device__ __forceinline__ void gemm_core144(const bf16_t* __restrict__ A, int lda, const bf16_t* __restrict__ Bt, int ldb,
                                             int K, f32x4 (&acc)[9][2], char* smem) {
  bf16_t* sA = (bf16_t*)smem;
  bf16_t* sB = sA + 2 * 144 * LDS_STRIDE;
  const int tid = otid(), lane = tid & 63, wave = tid >> 6;
  const int lr = tid >> 3, kc = tid & 7;
  const int nk = K >> 6;
  const int fr = lane & 15;
  const int rswz = (fr >> 1) & 7;
  const int fo0 = ((lane >> 4) ^ rswz) * 8, fo1 = ((4 + (lane >> 4)) ^ rswz) * 8;
  const bf16_t* cA = sA + fr * LDS_STRIDE;
  const bf16_t* cB = sB + (wave * 32 + fr) * LDS_STRIDE;
  constexpr int ABUF = 144 * LDS_STRIDE, BBUF = 128 * LDS_STRIDE;
  const bf16_t* ap = A + (size_t)lr * lda + kc * 8;
  const bf16_t* bp = Bt + (size_t)lr * ldb + kc * 8;
  const int wsw = (lr >> 1) & 7;
  bf16_t* wA = sA + lr * LDS_STRIDE + ((kc ^ wsw) * 8);
  bf16_t* wB = sB + lr * LDS_STRIDE + ((kc ^ wsw) * 8);
  const bool extra = tid < 128;
  u32x4 ra[5], rb[4];
  ra[4] = (u32x4){0u, 0u, 0u, 0u};
#define G144(kt_)                                                                              \
  {                                                                                            \
    const int kk_ = min((kt_), nk - 1) << 6;                                                   \
    _Pragma("unroll") for (int i = 0; i < 4; ++i) {                                            \
      ra[i] = *(const u32x4*)(ap + (size_t)(32 * i) * lda + kk_);                              \
      rb[i] = *(const u32x4*)(bp + (size_t)(32 * i) * ldb + kk_);                              \
    }                                                                                          \
    if (extra) ra[4] = *(const u32x4*)(ap + (size_t)128 * lda + kk_);                          \
  }
#define W144(buf_)                                                                             \
  {                                                                                            \
    _Pragma("unroll") for (int i = 0; i < 4; ++i) {                                            \
      *(u32x4*)(wA + (buf_) * ABUF + 32 * i * LDS_STRIDE) = ra[i];                             \
      *(u32x4*)(wB + (buf_) * BBUF + 32 * i * LDS_STRIDE) = rb[i];                             \
    }                                                                                          \
    if (extra) *(u32x4*)(wA + (buf_) * ABUF + 128 * LDS_STRIDE) = ra[4];                       \
  }
  G144(0);
  __syncthreads();
  W144(0);
  __syncthreads();
  for (int kt = 0; kt < nk; ++kt) {
    const int cur = kt & 1;
    G144(kt + 1);
#pragma unroll
    for (int ks = 0; ks < 2; ++ks) {
      const int fo = ks ? fo1 : fo0;
      bf16x8 bfr[2];
#pragma unroll
      for (int j = 0; j < 2; ++j) bfr[j] = *(const bf16x8*)(cB + cur * BBUF + j * 16 * LDS_STRIDE + fo);
#pragma unroll
      for (int i = 0; i < 9; ++i) {
        const bf16x8 af = *(const bf16x8*)(cA + cur * ABUF + i * 16 * LDS_STRIDE + fo);
#pragma unroll
        for (int j = 0; j < 2; ++j)
          acc[i][j] = __builtin_amdgcn_mfma_f32_16x16x32_bf16(bfr[j], af, acc[i][j], 0, 0, 0);
      }
    }
    if (kt + 1 < nk) { W144(cur ^ 1); }
    __syncthreads();
  }
#undef G144
#undef W144
}

__device__ __forceinline__ int inproj_src_col(int np) {
  if (np < PRE_W) {
    if (np < 1664) return np;
    if (np < 2688) return np - 1664 + 2688;
    if (np < 4224) return np - 2688 + 3720;
    if (np < 4232) return np - 4224 + 3712;
    if (np < 4240) return np - 4232 + 5768;
    return -1;
  }
  const int j = np - PRE_W;
  if (j < 512) return 1664 + j;
  if (j < 1024) return 2176 + (j - 512);
  if (j < 1536) return 5256 + (j - 1024);
  return 5776 + (j - 1536);
}

template <bool INPROJ>
__device__ __forceinline__ void convert_tile(const float* __restrict__ src, int src_ld, int n0, int k0,
                                             bf16_t* __restrict__ dst, int dst_ld, char* smem) {
  float* tile = (float*)smem;
  const int tid = otid();
  const int nn = tid & 63;
  int sc = INPROJ ? inproj_src_col(n0 + nn) : (n0 + nn);
#pragma unroll
  for (int i = 0; i < 16; ++i) {
    const int kk = (tid >> 6) + 4 * i;
    float v = 0.f;
    if (sc >= 0) v = src[(size_t)(k0 + kk) * src_ld + sc];
    tile[kk * 65 + nn] = v;
  }
  __syncthreads();
#pragma unroll
  for (int i = 0; i < 8; ++i) {
    const int n2 = (tid >> 5) + 8 * i;
    const int k2 = (tid & 31) * 2;
    const unsigned pk = pack2(tile[k2 * 65 + n2], tile[(k2 + 1) * 65 + n2]);
    *(unsigned*)(dst + (size_t)(n0 + n2) * dst_ld + k0 + k2) = pk;
  }
  __syncthreads();
}

__device__ __forceinline__ void phase_norm_convert(const Params& p, int l, char* smem) {
  const int tid = otid(), lane = tid & 63, wave = tid >> 6;
  float* X = (float*)(p.ws + OFF_X);
  bf16_t* H = (bf16_t*)(p.ws + OFF_H);
  const int n_row_items = NT / 4;
  const int n_in = (NPAD / 64) * 16, n_br = 3 * 16 * 8, n_out = 16 * 16;
  const int n_lora = 16;
  const int total = n_row_items + n_in + n_br + n_out + n_lora;
  for (int it = blockIdx.x; it < total; it += gridDim.x) {
    if (it < n_row_items) {
      const int row = it * 4 + wave;
      const float* src;
      if (l == 0) {
        if (row < NTP) {
          const int b = row / LP, t = row - b * LP;
          src = (t < 16) ? (p.in[8] + (size_t)t * 1024) : (p.in[0] + ((size_t)b * 2048 + (t - 16)) * 1024);
        } else {
          src = p.in[1] + (size_t)(row - NTP) * 1024;
        }
      } else {
        src = X + (size_t)row * 1024;
      }
      float4 v[4];
      float ss = 0.f;
#pragma unroll
      for (int i = 0; i < 4; ++i) {
        v[i] = ((const float4*)src)[lane + 64 * i];
        ss += v[i].x * v[i].x + v[i].y * v[i].y + v[i].z * v[i].z + v[i].w * v[i].w;
      }
      ss = wave_sum(ss);
      const float rs = rsqrtf(ss * (1.f / 1024.f) + 1e-6f);
      const float4* nw = (const float4*)(p.in[9] + (size_t)l * 1024);
#pragma unroll
      for (int i = 0; i < 4; ++i) {
        if (l == 0) ((float4*)(X + (size_t)row * 1024))[lane + 64 * i] = v[i];
        const float4 w = nw[lane + 64 * i];
        uint2 o;
        o.x = pack2(v[i].x * rs * w.x, v[i].y * rs * w.y);
        o.y = pack2(v[i].z * rs * w.z, v[i].w * rs * w.w);
        *(uint2*)(H + (size_t)row * 1024 + (lane + 64 * i) * 4) = o;
      }
    } else {
      int t = it - n_row_items;
      if (t < n_in) {
        if (l == 0) {
          const int nt = t >> 4, kt = t & 15;
          convert_tile<true>(p.in[10] + (size_t)l * 1024 * DPROJ, DPROJ, nt * 64, kt * 64,
                             (bf16_t*)(p.ws + OFF_WIN), 1024, smem);
        }
      } else if (t < n_in + n_br) {
        t -= n_in;
        const int b = t / 128, r = t - b * 128;
        const int nt = r >> 3, kt = r & 7;
        convert_tile<false>(p.in[31 + b] + (size_t)l * 512 * 1024, 1024, nt * 64, kt * 64,
                            (bf16_t*)(p.ws + OFF_WBR) + (size_t)b * 1024 * 512, 512, smem);
      } else if (t < n_in + n_br + n_out) {
        t -= n_in + n_br;
        const int nt = t >> 4, kt = t & 15;
        convert_tile<false>(p.in[34] + (size_t)l * 1024 * 1024, 1024, nt * 64, kt * 64,
                            (bf16_t*)(p.ws + OFF_WOUT), 1024, smem);
      } else {
        t -= n_in + n_br + n_out;
        if (l == 0) {
          const int which = t >> 3, nt = t & 7;
          convert_tile<false>(p.in[which ? 15 : 13] + (size_t)l * 64 * 512, 512, nt * 64, 0,
                              (bf16_t*)(p.ws + (which ? OFF_A2T : OFF_W2T)), 64, smem);
        }
      }
    }
  }
}

__device__ __forceinline__ void phase_gemm_in(const Params& p, char* smem) {
  const bf16_t* H = (const bf16_t*)(p.ws + OFF_H);
  const bf16_t* W = (const bf16_t*)(p.ws + OFF_WIN);
  bf16_t* PRE = (bf16_t*)(p.ws + OFF_PRE);
  bf16_t* POST = (bf16_t*)(p.ws + OFF_POST);
  const int tid_ = otid(); const int lane = tid_ & 63, wave = tid_ >> 6, wm = wave >> 1, wn = wave & 1;
  const int MT = NT / 256, NTn = NPAD / 128;
  const int iters = tile_iters(MT, NTn);
  for (int it = 0; it < iters; ++it) {
    int mt, nt;
    if (!tile_at(it, MT, NTn, mt, nt)) break;
    f32x4 acc[8][4];
#pragma unroll
    for (int i = 0; i < 8; ++i)
#pragma unroll
      for (int j = 0; j < 4; ++j) acc[i][j] = (f32x4){0.f, 0.f, 0.f, 0.f};
    gemm_core_big(H + (size_t)mt * 256 * 1024, 1024, W + (size_t)nt * 128 * 1024, 1024, 1024, acc, smem);
    bf16_t* dst; int ldd, ncol0;
    if (nt < PRE_W / 128) { dst = PRE; ldd = PRE_W; ncol0 = nt * 128; }
    else { dst = POST; ldd = POST_W; ncol0 = (nt - PRE_W / 128) * 128; }
#pragma unroll
    for (int i = 0; i < 8; ++i) {
      const int m = mt * 256 + wm * 128 + i * 16 + (lane & 15);
#pragma unroll
      for (int j = 0; j < 4; ++j) {
        const int n = ncol0 + wn * 64 + j * 16 + (lane >> 4) * 4;
        uint2 o;
        o.x = pack2(acc[i][j][0], acc[i][j][1]);
        o.y = pack2(acc[i][j][2], acc[i][j][3]);
        *(uint2*)(dst + (size_t)m * ldd + n) = o;
      }
    }
  }
}

__device__ __forceinline__ void prep_rwkv(const Params& p, int l, int item, char* smem) {
  bf16_t* sA = (bf16_t*)smem;
  float* sW = (float*)(smem + 4352);
  float* sAs = sW + 16 * 516;
  const int tid = otid(), lane = tid & 63, wave = tid >> 6;
  const int row0 = item * 16;
  const bf16_t* PRE = (const bf16_t*)(p.ws + OFF_PRE);
  const float* mu = p.in[11] + (size_t)l * 1664;
  const float* shift_in = p.in[3] + (size_t)l * 128 * 1664;
  float* RWW = (float*)(p.ws + OFF_RWW);
  bf16_t* RW5 = (bf16_t*)(p.ws + OFF_RW5);
  float* RWSC = (float*)(p.ws + OFF_RWSC);
  const bf16_t* W2T = (const bf16_t*)(p.ws + OFF_W2T);
  const bf16_t* A2T = (const bf16_t*)(p.ws + OFF_A2T);

  __syncthreads();
  {
    const int tok = tid >> 4, c8 = (tid & 15) * 8;
    const int row = row0 + tok;
    int seq, t; row_to_seq(row, seq, t);
    const int col = 1536 + c8;
    const u32x4 pv = *(const u32x4*)(PRE + (size_t)row * PRE_W + col);
    float x[8], pr[8];
    x[0] = bflo(pv.x); x[1] = bfhi(pv.x); x[2] = bflo(pv.y); x[3] = bfhi(pv.y);
    x[4] = bflo(pv.z); x[5] = bfhi(pv.z); x[6] = bflo(pv.w); x[7] = bfhi(pv.w);
    if (t > 0) {
      const u32x4 pp = *(const u32x4*)(PRE + (size_t)(row - 1) * PRE_W + col);
      pr[0] = bflo(pp.x); pr[1] = bfhi(pp.x); pr[2] = bflo(pp.y); pr[3] = bfhi(pp.y);
      pr[4] = bflo(pp.z); pr[5] = bfhi(pp.z); pr[6] = bflo(pp.w); pr[7] = bfhi(pp.w);
    } else if (seq >= 8) {
      const float4 h0 = *(const float4*)(shift_in + (size_t)(seq - 8) * 1664 + col);
      const float4 h1 = *(const float4*)(shift_in + (size_t)(seq - 8) * 1664 + col + 4);
      pr[0] = h0.x; pr[1] = h0.y; pr[2] = h0.z; pr[3] = h0.w; pr[4] = h1.x; pr[5] = h1.y; pr[6] = h1.z; pr[7] = h1.w;
    } else {
#pragma unroll
      for (int j = 0; j < 8; ++j) pr[j] = 0.f;
    }
    const float4 m0 = *(const float4*)(mu + col), m1 = *(const float4*)(mu + col + 4);
    const float mm[8] = {m0.x, m0.y, m0.z, m0.w, m1.x, m1.y, m1.z, m1.w};
    float u[8];
#pragma unroll
    for (int j = 0; j < 8; ++j) {
      u[j] = x[j] + (pr[j] - x[j]) * mm[j];
      if (c8 < 64) u[j] = ftanh_(u[j]);
    }
    u32x4 o;
    o.x = pack2(u[0], u[1]); o.y = pack2(u[2], u[3]); o.z = pack2(u[4], u[5]); o.w = pack2(u[6], u[7]);
    *(u32x4*)(sA + tok * 136 + c8) = o;
  }
  __syncthreads();
  {
    const int fr = lane & 15, fq = (lane >> 4) * 8;
    bf16x8 atw[2], aad[2];
#pragma unroll
    for (int ks = 0; ks < 2; ++ks) {
      atw[ks] = *(const bf16x8*)(sA + fr * 136 + ks * 32 + fq);
      aad[ks] = *(const bf16x8*)(sA + fr * 136 + 64 + ks * 32 + fq);
    }
    const float* w0 = p.in[12] + (size_t)l * 512;
    const float* a0 = p.in[14] + (size_t)l * 512;
#pragma unroll
    for (int jt = 0; jt < 8; ++jt) {
      const int n = wave * 128 + jt * 16 + fr;
      f32x4 cw = (f32x4){0.f, 0.f, 0.f, 0.f}, ca = (f32x4){0.f, 0.f, 0.f, 0.f};
#pragma unroll
      for (int ks = 0; ks < 2; ++ks) {
        const bf16x8 bw = *(const bf16x8*)(W2T + (size_t)n * 64 + ks * 32 + fq);
        const bf16x8 ba = *(const bf16x8*)(A2T + (size_t)n * 64 + ks * 32 + fq);
        cw = __builtin_amdgcn_mfma_f32_16x16x32_bf16(atw[ks], bw, cw, 0, 0, 0);
        ca = __builtin_amdgcn_mfma_f32_16x16x32_bf16(aad[ks], ba, ca, 0, 0, 0);
      }
      const float w0v = w0[n], a0v = a0[n];
#pragma unroll
      for (int r = 0; r < 4; ++r) {
        const int tok = (lane >> 4) * 4 + r;
        const float wl = w0v + cw[r];
        const float wv = -softplusf_(-wl) - 0.5f;
        sW[tok * 516 + n] = __expf(-__expf(wv));
        sAs[tok * 516 + n] = sigmoidf_(a0v + ca[r]);
      }
    }
  }
  __syncthreads();
  {
    const int chunk = tid & 127, ch4 = chunk * 4, head = chunk >> 4;
    const float4 mur = *(const float4*)(mu + ch4), muk = *(const float4*)(mu + 512 + ch4), muv = *(const float4*)(mu + 1024 + ch4);
    const float4 kkc = *(const float4*)(p.in[16] + (size_t)l * 512 + ch4);
    const float4 kac = *(const float4*)(p.in[17] + (size_t)l * 512 + ch4);
    const float4 rkc = *(const float4*)(p.in[18] + (size_t)l * 512 + ch4);
#pragma unroll
    for (int i = 0; i < 8; ++i) {
      const int tok = (tid >> 7) + 2 * i;
      const int row = row0 + tok;
      int seq, t; row_to_seq(row, seq, t);
      const uint2 pr_ = *(const uint2*)(PRE + (size_t)row * PRE_W + ch4);
      const uint2 pk_ = *(const uint2*)(PRE + (size_t)row * PRE_W + 512 + ch4);
      const uint2 pv_ = *(const uint2*)(PRE + (size_t)row * PRE_W + 1024 + ch4);
      float4 qr, qk, qv;
      if (t > 0) {
        const uint2 a_ = *(const uint2*)(PRE + (size_t)(row - 1) * PRE_W + ch4);
        const uint2 b_ = *(const uint2*)(PRE + (size_t)(row - 1) * PRE_W + 512 + ch4);
        const uint2 c_ = *(const uint2*)(PRE + (size_t)(row - 1) * PRE_W + 1024 + ch4);
        qr = make_float4(bflo(a_.x), bfhi(a_.x), bflo(a_.y), bfhi(a_.y));
        qk = make_float4(bflo(b_.x), bfhi(b_.x), bflo(b_.y), bfhi(b_.y));
        qv = make_float4(bflo(c_.x), bfhi(c_.x), bflo(c_.y), bfhi(c_.y));
      } else if (seq >= 8) {
        const float* sh = shift_in + (size_t)(seq - 8) * 1664;
        qr = *(const float4*)(sh + ch4); qk = *(const float4*)(sh + 512 + ch4); qv = *(const float4*)(sh + 1024 + ch4);
      } else {
        qr = qk = qv = make_float4(0.f, 0.f, 0.f, 0.f);
      }
      const float4 dec = *(const float4*)(sW + tok * 516 + ch4);
      const float4 as = *(const float4*)(sAs + tok * 516 + ch4);
      const float pr4[4] = {bflo(pr_.x), bfhi(pr_.x), bflo(pr_.y), bfhi(pr_.y)};
      const float pk4[4] = {bflo(pk_.x), bfhi(pk_.x), bflo(pk_.y), bfhi(pk_.y)};
      const float pv4[4] = {bflo(pv_.x), bfhi(pv_.x), bflo(pv_.y), bfhi(pv_.y)};
      const float qr4[4] = {qr.x, qr.y, qr.z, qr.w}, qk4[4] = {qk.x, qk.y, qk.z, qk.w}, qv4[4] = {qv.x, qv.y, qv.z, qv.w};
      const float mr4[4] = {mur.x, mur.y, mur.z, mur.w}, mk4[4] = {muk.x, muk.y, muk.z, muk.w}, mv4[4] = {muv.x, muv.y, muv.z, muv.w};
      const float kk4[4] = {kkc.x, kkc.y, kkc.z, kkc.w}, ka4[4] = {kac.x, kac.y, kac.z, kac.w}, rk4[4] = {rkc.x, rkc.y, rkc.z, rkc.w};
      const float de4[4] = {dec.x, dec.y, dec.z, dec.w}, as4[4] = {as.x, as.y, as.z, as.w};
      float r[4], kx[4], v[4], kkr[4];
      float ssq = 0.f;
#pragma unroll
      for (int j = 0; j < 4; ++j) {
        r[j] = pr4[j] + (qr4[j] - pr4[j]) * mr4[j];
        kx[j] = pk4[j] + (qk4[j] - pk4[j]) * mk4[j];
        v[j] = pv4[j] + (qv4[j] - pv4[j]) * mv4[j];
        kkr[j] = kx[j] * kk4[j];
        ssq += kkr[j] * kkr[j];
      }
      ssq = red16(ssq);
      const float rn = rsqrtf(ssq + 1e-6f);
      float fA[4], fWR[4], fB[4], fK[4];
      float br = 0.f, kr = 0.f, rks = 0.f;
#pragma unroll
      for (int j = 0; j < 4; ++j) {
        const float kk = kkr[j] * rn;
        const float kp = kx[j] * (1.f + (as4[j] - 1.f) * ka4[j]);
        fA[j] = -kk; fWR[j] = de4[j] * r[j]; fB[j] = kk * as4[j]; fK[j] = kp;
        br += rbf(fB[j]) * r[j];
        kr += rbf(fK[j]) * r[j];
        rks += r[j] * kp * rk4[j];
      }
      br = red16(br); kr = red16(kr); rks = red16(rks);
      *(float4*)(RWW + (size_t)row * 512 + ch4) = dec;
      bf16_t* d5 = RW5 + (size_t)row * 5 * 512 + ch4;
      *(uint2*)(d5) = make_uint2(pack2(fA[0], fA[1]), pack2(fA[2], fA[3]));
      *(uint2*)(d5 + 512) = make_uint2(pack2(fWR[0], fWR[1]), pack2(fWR[2], fWR[3]));
      *(uint2*)(d5 + 1024) = make_uint2(pack2(fB[0], fB[1]), pack2(fB[2], fB[3]));
      *(uint2*)(d5 + 1536) = make_uint2(pack2(fK[0], fK[1]), pack2(fK[2], fK[3]));
      *(uint2*)(d5 + 2048) = make_uint2(pack2(v[0], v[1]), pack2(v[2], v[3]));
      if ((chunk & 15) == 0) *(float4*)(RWSC + ((size_t)row * 8 + head) * 4) = make_float4(br, kr, rks, 0.f);
    }
  }
  if (row0 >= NTP) {
    for (int idx = tid; idx < 16 * 416; idx += 256) {
      const int tok = idx / 416, c4 = (idx - tok * 416) * 4;
      const int row = row0 + tok;
      const uint2 u = *(const uint2*)(PRE + (size_t)row * PRE_W + c4);
      *(float4*)(p.out + O_S_SHIFT + ((size_t)l * 128 + (row - NTP)) * 1664 + c4) =
          make_float4(bflo(u.x), bfhi(u.x), bflo(u.y), bfhi(u.y));
    }
  } else {
    const int seq = row0 / LP, t0 = row0 - seq * LP;
    if (t0 + 16 == LP) {
      const int row = row0 + 15;
      for (int c4 = tid * 4; c4 < 1664; c4 += 1024) {
        const uint2 u = *(const uint2*)(PRE + (size_t)row * PRE_W + c4);
        *(float4*)(p.out + O_P_SHIFT + ((size_t)l * 8 + seq) * 1664 + c4) = make_float4(bflo(u.x), bfhi(u.x), bflo(u.y), bfhi(u.y));
      }
    }
  }
}

__device__ __forceinline__ void prep_conv_token(const Params& p, int l, int row, int tid, int lane, int wave) {
  const bf16_t* PRE = (const bf16_t*)(p.ws + OFF_PRE);
  bf16_t* SXBC = (bf16_t*)(p.ws + OFF_SXBC);
  float* SDT = (float*)(p.ws + OFF_SDT);
  bf16_t* GQKV = (bf16_t*)(p.ws + OFF_GQKV);
  float* GSC = (float*)(p.ws + OFF_GSC);
  const float* scw = p.in[21] + (size_t)l * 4 * 1024;
  const float* scb = p.in[22] + (size_t)l * 1024;
  const float* gcw = p.in[27] + (size_t)l * 4 * 1536;
  const float* shist = p.in[5] + (size_t)l * 128 * 3 * 1024;
  const float* ghist = p.in[7] + (size_t)l * 128 * 3 * 1536;
  const int b = row - NTP;
  {
    const int c = tid * 4;
    float acc[4] = {scb[c], scb[c + 1], scb[c + 2], scb[c + 3]};
    float cur[4];
    {
      const uint2 u = *(const uint2*)(PRE + (size_t)row * PRE_W + PC_XBC + c);
      cur[0] = bflo(u.x); cur[1] = bfhi(u.x); cur[2] = bflo(u.y); cur[3] = bfhi(u.y);
      const float4 w = *(const float4*)(scw + (size_t)3 * 1024 + c);
      acc[0] += cur[0] * w.x; acc[1] += cur[1] * w.y; acc[2] += cur[2] * w.z; acc[3] += cur[3] * w.w;
    }
    float* o2 = p.out + O_S_SCONV + ((size_t)l * 128 + b) * 3 * 1024;
#pragma unroll
    for (int j = 0; j < 3; ++j) {
      const float4 h = *(const float4*)(shist + ((size_t)b * 3 + j) * 1024 + c);
      const float4 w = *(const float4*)(scw + (size_t)j * 1024 + c);
      acc[0] += h.x * w.x; acc[1] += h.y * w.y; acc[2] += h.z * w.z; acc[3] += h.w * w.w;
      if (j > 0) *(float4*)(o2 + (j - 1) * 1024 + c) = h;
    }
    *(float4*)(o2 + 2 * 1024 + c) = make_float4(cur[0], cur[1], cur[2], cur[3]);
    uint2 o;
    o.x = pack2(siluf_(acc[0]), siluf_(acc[1]));
    o.y = pack2(siluf_(acc[2]), siluf_(acc[3]));
    *(uint2*)(SXBC + (size_t)row * 1024 + c) = o;
    if (tid < 8) {
      const float dtv = softplusf_(bf2f(PRE[(size_t)row * PRE_W + PC_DT + tid]) + p.in[23][l * 8 + tid]);
      const float a = -__expf(p.in[24][l * 8 + tid]);
      SDT[(size_t)row * 16 + tid * 2 + 0] = dtv;
      SDT[(size_t)row * 16 + tid * 2 + 1] = __expf(dtv * a);
    }
  }
  {
    float val[3][2];
    float* o2 = p.out + O_S_GCONV + ((size_t)l * 128 + b) * 3 * 1536;
#pragma unroll
    for (int i = 0; i < 3; ++i) {
      const int c = 2 * tid + 512 * i;
      const unsigned u = *(const unsigned*)(PRE + (size_t)row * PRE_W + PC_QKV + c);
      const float c0 = bflo(u), c1 = bfhi(u);
      const float2 w3 = *(const float2*)(gcw + (size_t)3 * 1536 + c);
      float acc0 = c0 * w3.x, acc1 = c1 * w3.y;
#pragma unroll
      for (int j = 0; j < 3; ++j) {
        const float2 h = *(const float2*)(ghist + ((size_t)b * 3 + j) * 1536 + c);
        const float2 w = *(const float2*)(gcw + (size_t)j * 1536 + c);
        acc0 += h.x * w.x; acc1 += h.y * w.y;
        if (j > 0) *(float2*)(o2 + (j - 1) * 1536 + c) = h;
      }
      *(float2*)(o2 + 2 * 1536 + c) = make_float2(c0, c1);
      val[i][0] = siluf_(acc0); val[i][1] = siluf_(acc1);
    }
    const float ssq = wave_sum(val[0][0] * val[0][0] + val[0][1] * val[0][1]);
    const float ssk = wave_sum(val[1][0] * val[1][0] + val[1][1] * val[1][1]);
    const float rq = rsqrtf(ssq + 1e-6f) * 0.08838834764831845f;
    const float rk = rsqrtf(ssk + 1e-6f);
    const unsigned uq = pack2(val[0][0] * rq, val[0][1] * rq);
    const unsigned uk = pack2(val[1][0] * rk, val[1][1] * rk);
    const unsigned uv = pack2(val[2][0], val[2][1]);
    const float qk = wave_sum(bflo(uq) * bflo(uk) + bfhi(uq) * bfhi(uk));
    *(unsigned*)(GQKV + (size_t)row * 1536 + 2 * tid) = uq;
    *(unsigned*)(GQKV + (size_t)row * 1536 + 512 + 2 * tid) = uk;
    *(unsigned*)(GQKV + (size_t)row * 1536 + 1024 + 2 * tid) = uv;
    if (lane == 0) {
      const int h = wave;
      const float g = -__expf(p.in[29][l * 4 + h]) *
                      softplusf_(bf2f(PRE[(size_t)row * PRE_W + PC_GA + h]) + p.in[28][l * 4 + h]);
      *(float4*)(GSC + ((size_t)row * 4 + h) * 4) =
          make_float4(__expf(g), sigmoidf_(bf2f(PRE[(size_t)row * PRE_W + PC_GB + h])), qk, 0.f);
    }
  }
}

__device__ __forceinline__ void prep_conv(const Params& p, int l, int item) {
  const int tid = otid(), lane = tid & 63, wave = tid >> 6;
  const int row0 = item * 8;
  if (row0 >= NTP) {
    for (int k = 0; k < 8; ++k) prep_conv_token(p, l, row0 + k, tid, lane, wave);
    return;
  }
  const bf16_t* PRE = (const bf16_t*)(p.ws + OFF_PRE);
  bf16_t* SXBC = (bf16_t*)(p.ws + OFF_SXBC);
  float* SDT = (float*)(p.ws + OFF_SDT);
  bf16_t* GQKV = (bf16_t*)(p.ws + OFF_GQKV);
  float* GSC = (float*)(p.ws + OFF_GSC);
  const int seq = row0 / LP, t0 = row0 - seq * LP;
  {
    const int c = tid * 4;
    const float* scw = p.in[21] + (size_t)l * 4 * 1024;
    const float4 w0 = *(const float4*)(scw + c), w1 = *(const float4*)(scw + 1024 + c);
    const float4 w2 = *(const float4*)(scw + 2048 + c), w3 = *(const float4*)(scw + 3072 + c);
    const float4 bs = *(const float4*)(p.in[22] + (size_t)l * 1024 + c);
    uint2 x[11];
#pragma unroll
    for (int j = 0; j < 11; ++j) {
      x[j] = make_uint2(0u, 0u);
      if (t0 - 3 + j >= 0) x[j] = *(const uint2*)(PRE + (size_t)(row0 - 3 + j) * PRE_W + PC_XBC + c);
    }
#pragma unroll
    for (int k = 0; k < 8; ++k) {
      const float a0 = bs.x + bflo(x[k].x) * w0.x + bflo(x[k + 1].x) * w1.x + bflo(x[k + 2].x) * w2.x + bflo(x[k + 3].x) * w3.x;
      const float a1 = bs.y + bfhi(x[k].x) * w0.y + bfhi(x[k + 1].x) * w1.y + bfhi(x[k + 2].x) * w2.y + bfhi(x[k + 3].x) * w3.y;
      const float a2 = bs.z + bflo(x[k].y) * w0.z + bflo(x[k + 1].y) * w1.z + bflo(x[k + 2].y) * w2.z + bflo(x[k + 3].y) * w3.z;
      const float a3 = bs.w + bfhi(x[k].y) * w0.w + bfhi(x[k + 1].y) * w1.w + bfhi(x[k + 2].y) * w2.w + bfhi(x[k + 3].y) * w3.w;
      uint2 o;
      o.x = pack2(siluf_(a0), siluf_(a1));
      o.y = pack2(siluf_(a2), siluf_(a3));
      *(uint2*)(SXBC + (size_t)(row0 + k) * 1024 + c) = o;
    }
    if (t0 + 8 == LP) {
#pragma unroll
      for (int j = 0; j < 3; ++j) {
        const uint2 u = x[8 + j];
        *(float4*)(p.out + O_P_SCONV + (((size_t)l * 8 + seq) * 3 + j) * 1024 + c) =
            make_float4(bflo(u.x), bfhi(u.x), bflo(u.y), bfhi(u.y));
      }
    }
    if (tid < 64) {
      const int tok = tid >> 3, h = tid & 7;
      const int row = row0 + tok;
      const float dtv = softplusf_(bf2f(PRE[(size_t)row * PRE_W + PC_DT + h]) + p.in[23][l * 8 + h]);
      const float a = -__expf(p.in[24][l * 8 + h]);
      SDT[(size_t)row * 16 + h * 2 + 0] = dtv;
      SDT[(size_t)row * 16 + h * 2 + 1] = __expf(dtv * a);
    }
  }
  {
    const float* gcw = p.in[27] + (size_t)l * 4 * 1536;
    unsigned x[3][11];
    float2 w[3][4];
#pragma unroll
    for (int i = 0; i < 3; ++i) {
      const int c = 2 * tid + 512 * i;
#pragma unroll
      for (int j = 0; j < 4; ++j) w[i][j] = *(const float2*)(gcw + (size_t)j * 1536 + c);
#pragma unroll
      for (int j = 0; j < 11; ++j) {
        x[i][j] = 0u;
        if (t0 - 3 + j >= 0) x[i][j] = *(const unsigned*)(PRE + (size_t)(row0 - 3 + j) * PRE_W + PC_QKV + c);
      }
    }
    if (t0 + 8 == LP) {
#pragma unroll
      for (int i = 0; i < 3; ++i)
#pragma unroll
        for (int j = 0; j < 3; ++j)
          *(float2*)(p.out + O_P_GCONV + (((size_t)l * 8 + seq) * 3 + j) * 1536 + 2 * tid + 512 * i) =
              make_float2(bflo(x[i][8 + j]), bfhi(x[i][8 + j]));
    }
    const float nega = -__expf(p.in[29][l * 4 + wave]);
    const float dtb = p.in[28][l * 4 + wave];
#pragma unroll
    for (int k = 0; k < 8; ++k) {
      float val[3][2];
#pragma unroll
      for (int i = 0; i < 3; ++i) {
        const float a0 = bflo(x[i][k]) * w[i][0].x + bflo(x[i][k + 1]) * w[i][1].x + bflo(x[i][k + 2]) * w[i][2].x + bflo(x[i][k + 3]) * w[i][3].x;
        const float a1 = bfhi(x[i][k]) * w[i][0].y + bfhi(x[i][k + 1]) * w[i][1].y + bfhi(x[i][k + 2]) * w[i][2].y + bfhi(x[i][k + 3]) * w[i][3].y;
        val[i][0] = siluf_(a0); val[i][1] = siluf_(a1);
      }
      const int row = row0 + k;
      const float ssq = wave_sum(val[0][0] * val[0][0] + val[0][1] * val[0][1]);
      const float ssk = wave_sum(val[1][0] * val[1][0] + val[1][1] * val[1][1]);
      const float rq = rsqrtf(ssq + 1e-6f) * 0.08838834764831845f;
      const float rk = rsqrtf(ssk + 1e-6f);
      const unsigned uq = pack2(val[0][0] * rq, val[0][1] * rq);
      const unsigned uk = pack2(val[1][0] * rk, val[1][1] * rk);
      const unsigned uv = pack2(val[2][0], val[2][1]);
      const float qk = wave_sum(bflo(uq) * bflo(uk) + bfhi(uq) * bfhi(uk));
      *(unsigned*)(GQKV + (size_t)row * 1536 + 2 * tid) = uq;
      *(unsigned*)(GQKV + (size_t)row * 1536 + 512 + 2 * tid) = uk;
      *(unsigned*)(GQKV + (size_t)row * 1536 + 1024 + 2 * tid) = uv;
      if (lane == 0) {
        const int h = wave;
        const float g = nega * softplusf_(bf2f(PRE[(size_t)row * PRE_W + PC_GA + h]) + dtb);
        *(float4*)(GSC + ((size_t)row * 4 + h) * 4) =
            make_float4(__expf(g), sigmoidf_(bf2f(PRE[(size_t)row * PRE_W + PC_GB + h])), qk, 0.f);
      }
    }
  }
}

__device__ __forceinline__ void phase_prep(const Params& p, int l, char* smem) {
  const int ng = NT / 16;
  const int nc = NT / 8;
  for (int it = blockIdx.x; it < ng + nc; it += gridDim.x) {
    if (it < ng) prep_rwkv(p, l, it, smem); else prep_conv(p, l, it - ng);
  }
}

using f32x2 = __attribute__((ext_vector_type(2))) float;
__device__ __forceinline__ f32x2 lo2(const f32x4& v) { return __builtin_shufflevector(v, v, 0, 1); }
__device__ __forceinline__ f32x2 hi2(const f32x4& v) { return __builtin_shufflevector(v, v, 2, 3); }
__device__ __forceinline__ f32x2 splat2(float x) { return (f32x2){x, x}; }

__device__ __forceinline__ void cvt8(const u32x4& u, float4& lo, float4& hi) {
  lo = make_float4(bflo(u.x), bfhi(u.x), bflo(u.y), bfhi(u.y));
  hi = make_float4(bflo(u.z), bfhi(u.z), bflo(u.w), bfhi(u.w));
}

#define SCAN_INTERLEAVE(nds, nvalu)                                   \
  _Pragma("unroll") for (int i_ = 0; i_ < (nds); ++i_) {               \
    __builtin_amdgcn_sched_group_barrier(0x100, 1, 0);                 \
    __builtin_amdgcn_sched_group_barrier(0x002, (nvalu), 0);           \
  }
struct RwP { f32x4 pw; u32x4 pb[3]; float4 psc; uint2 zn; };
struct SsP { u32x4 pb[3]; float2 psc; uint2 zn; };
struct GdP { u32x4 pb[3]; float4 psc; unsigned zn; };
struct RwRegs { f32x4 a[2], wr[2], w[2], b[2], k[2]; f32x4 sc; f32x2 v; };
__device__ __forceinline__ void rw_load(RwRegs& R, const float* vb, const float* sb, int t, int k0, int vrow0) {
  const float* vt = vb + t * 384 + k0;
#pragma unroll
  for (int q = 0; q < 2; ++q) {
    R.a[q] = *(const f32x4*)(vt + q * 4);
    R.wr[q] = *(const f32x4*)(vt + 128 + q * 4);
    R.w[q] = *(const f32x4*)(vt + 64 + q * 4);
    R.b[q] = *(const f32x4*)(vt + 192 + q * 4);
    R.k[q] = *(const f32x4*)(vt + 256 + q * 4);
  }
  R.v = *(const f32x2*)(vb + t * 384 + 320 + vrow0);
  R.sc = *(const f32x4*)(sb + t * 4);
}
__device__ __forceinline__ f32x2 rw_step(f32x2 (&S)[2][4], const RwRegs& R) {
  float sa[2], sy[2];
#pragma unroll
  for (int r = 0; r < 2; ++r) {
    f32x2 a0 = S[r][0] * lo2(R.a[0]);
    f32x2 a1 = S[r][1] * hi2(R.a[0]);
    f32x2 y0 = S[r][0] * lo2(R.wr[0]);
    f32x2 y1 = S[r][1] * hi2(R.wr[0]);
    a0 += S[r][2] * lo2(R.a[1]);
    a1 += S[r][3] * hi2(R.a[1]);
    y0 += S[r][2] * lo2(R.wr[1]);
    y1 += S[r][3] * hi2(R.wr[1]);
    a0 += a1; y0 += y1;
    sa[r] = a0.x + a0.y; sy[r] = y0.x + y0.y;
  }
  sa[0] = red8(sa[0]); sa[1] = red8(sa[1]); sy[0] = red8(sy[0]); sy[1] = red8(sy[1]);
  f32x2 yv;
#pragma unroll
  for (int r = 0; r < 2; ++r) {
    const float vr = r ? R.v.y : R.v.x;
    const f32x2 sa2 = splat2(sa[r]), vv2 = splat2(vr);
    S[r][0] = S[r][0] * lo2(R.w[0]) + (sa2 * lo2(R.b[0]) + vv2 * lo2(R.k[0]));
    S[r][1] = S[r][1] * hi2(R.w[0]) + (sa2 * hi2(R.b[0]) + vv2 * hi2(R.k[0]));
    S[r][2] = S[r][2] * lo2(R.w[1]) + (sa2 * lo2(R.b[1]) + vv2 * lo2(R.k[1]));
    S[r][3] = S[r][3] * hi2(R.w[1]) + (sa2 * hi2(R.b[1]) + vv2 * hi2(R.k[1]));
    const float y = sy[r] + sa[r] * R.sc.x + vr * R.sc.y;
    if (r) yv.y = y; else yv.x = y;
  }
  return yv;
}

__device__ __forceinline__ void scan_rwkv(const Params& p, int l, int seq, int h, char* smem) {
  float* vec = (float*)smem;
  float* scb = vec + 2 * 16 * 384;
  float* yb = scb + 2 * 16 * 4;
  const int tid = otid(), lane = tid & 63, wave = tid >> 6;
  const int vrow0 = wave * 16 + (lane >> 3) * 2, part = lane & 7, k0 = part * 8;
  int T, row0; const float* st_in; float* st_out;
  if (seq < 8) { T = LP; row0 = seq * LP; st_in = nullptr; st_out = p.out + O_P_WKV + (((size_t)l * 8 + seq) * 8 + h) * 4096; }
  else { const int b = seq - 8; T = 1; row0 = NTP + b;
         st_in = p.in[2] + (((size_t)l * 128 + b) * 8 + h) * 4096;
         st_out = p.out + O_S_WKV + (((size_t)l * 128 + b) * 8 + h) * 4096; }
  f32x2 S[2][4];
  if (st_in) {
#pragma unroll
    for (int r = 0; r < 2; ++r)
#pragma unroll
      for (int q = 0; q < 2; ++q) {
        const f32x4 v = *(const f32x4*)(st_in + (vrow0 + r) * 64 + k0 + q * 4);
        S[r][2 * q] = lo2(v); S[r][2 * q + 1] = hi2(v);
      }
  } else {
#pragma unroll
    for (int r = 0; r < 2; ++r)
#pragma unroll
      for (int i = 0; i < 4; ++i) S[r][i] = splat2(0.f);
  }
  const float* RWW = (const float*)(p.ws + OFF_RWW);
  const bf16_t* RW5 = (const bf16_t*)(p.ws + OFF_RW5);
  const float* RWSC = (const float*)(p.ws + OFF_RWSC);
  const bf16_t* POST = (const bf16_t*)(p.ws + OFF_POST);
  bf16_t* BR = (bf16_t*)(p.ws + OFF_BR);
  const int st_t = tid >> 4, st_j = tid & 15;
  const float4 gw = *(const float4*)(p.in[19] + (size_t)l * 512 + h * 64 + st_j * 4);
  const float4 gb = *(const float4*)(p.in[20] + (size_t)l * 512 + h * 64 + st_j * 4);
  const int nch = (T + 15) >> 4;
  uint2 zc = make_uint2(0, 0);

  const int tcl = (T >= 16) ? 1 : 0;
  const int oW = (row0 + st_t * tcl) * 512 + h * 64 + st_j * 4;
  const int oZ = (row0 + st_t * tcl) * POST_W + QC_RWZ + h * 64 + st_j * 4;
  const int oS = ((row0 + (tid & 15) * tcl) * 8 + h) * 4;
  int oB[3];
#pragma unroll
  for (int i = 0; i < 3; ++i) {
    const int idx = (tid + 256 * i < 640) ? tid + 256 * i : 0;
    const int arr = idx >> 7, rem = idx & 127, tt = rem >> 3, chn = rem & 7;
    oB[i] = ((row0 + tt * tcl) * 5 + arr) * 512 + h * 64 + chn * 8;
  }
  auto prefetch = [&](RwP& P, int c)
  {
    const int cc = c * 16;
    P.pw = *(const f32x4*)(RWW + oW + cc * 512);
    P.zn = *(const uint2*)(POST + oZ + cc * POST_W);
    P.pb[0] = *(const u32x4*)(RW5 + oB[0] + cc * 2560);
    P.pb[1] = *(const u32x4*)(RW5 + oB[1] + cc * 2560);
    if (tid < 128) P.pb[2] = *(const u32x4*)(RW5 + oB[2] + cc * 2560);
    if (tid < 16) P.psc = *(const float4*)(RWSC + oS + cc * 32);
  };
  int sB_[3];
#pragma unroll
  for (int i = 0; i < 3; ++i) {
    const int idx = (tid + 256 * i < 640) ? tid + 256 * i : 0;
    const int arr = idx >> 7, rem = idx & 127, tt = rem >> 3, chn = rem & 7;
    sB_[i] = tt * 384 + ((arr == 0) ? 0 : arr + 1) * 64 + chn * 8;
  }
  const int sW_ = st_t * 384 + 64 + st_j * 4;
  auto stage = [&](const RwP& P, int buf)
  {
    float* vb_ = vec + buf * 16 * 384;
    *(f32x4*)(vb_ + sW_) = P.pw;
    float4 lo, hi;
    cvt8(P.pb[0], lo, hi); *(float4*)(vb_ + sB_[0]) = lo; *(float4*)(vb_ + sB_[0] + 4) = hi;
    cvt8(P.pb[1], lo, hi); *(float4*)(vb_ + sB_[1]) = lo; *(float4*)(vb_ + sB_[1] + 4) = hi;
    if (tid < 128) { cvt8(P.pb[2], lo, hi); *(float4*)(vb_ + sB_[2]) = lo; *(float4*)(vb_ + sB_[2] + 4) = hi; }
    if (tid < 16) *(float4*)(scb + buf * 64 + tid * 4) = P.psc;
  };
  RwP P0{}, P1{};
  __syncthreads();
  prefetch(P0, 0);
  stage(P0, 0);
  zc = P0.zn;
  if (nch > 1) prefetch(P1, 1);
  __syncthreads();
  auto body = [&](int c, RwP& Pfree, const RwP& Pfull) {
    const int cur = c & 1;
    prefetch(Pfree, min(c + 2, nch - 1));
    const int nsteps = min(16, T - c * 16);
    const float* vb = vec + cur * 16 * 384;
    const float* sb = scb + cur * 64;
    RwRegs RA, RB;
    float* ydummy = yb + 16 * 64 + tid * 2;
    rw_load(RA, vb, sb, 0, k0, vrow0);
    for (int t = 0; t < nsteps; t += 2) {
      rw_load(RB, vb, sb, min(t + 1, 15), k0, vrow0);
      const f32x2 y0v = rw_step(S, RA);
      *(f32x2*)((part == 0) ? (yb + t * 64 + vrow0) : ydummy) = y0v;
      SCAN_INTERLEAVE(13, 4);
      if (t + 1 < nsteps) {
        rw_load(RA, vb, sb, min(t + 2, 15), k0, vrow0);
        const f32x2 y1v = rw_step(S, RB);
        *(f32x2*)((part == 0) ? (yb + (t + 1) * 64 + vrow0) : ydummy) = y1v;
        SCAN_INTERLEAVE(13, 4);
      }
    }
    __syncthreads();
    {
      const int t = st_t, c4 = st_j * 4;
      const bool valid = t < nsteps;
      const float4 y = *(const float4*)(yb + t * 64 + c4);
      float s = red16(y.x + y.y + y.z + y.w);
      const float mean = s * (1.f / 64.f);
      const float d0 = y.x - mean, d1 = y.y - mean, d2 = y.z - mean, d3 = y.w - mean;
      const float var = red16(d0 * d0 + d1 * d1 + d2 * d2 + d3 * d3) * (1.f / 64.f);
      const float rstd = rsqrtf(var + 64e-5f);
      if (valid) {
        const int row = row0 + c * 16 + t;
        const float rks = sb[t * 4 + 2];
        const float4 v4 = *(const float4*)(vb + t * 384 + 320 + c4);
        const float o0 = (d0 * rstd * gw.x + gb.x + rks * v4.x) * siluf_(bflo(zc.x));
        const float o1 = (d1 * rstd * gw.y + gb.y + rks * v4.y) * siluf_(bfhi(zc.x));
        const float o2 = (d2 * rstd * gw.z + gb.z + rks * v4.z) * siluf_(bflo(zc.y));
        const float o3 = (d3 * rstd * gw.w + gb.w + rks * v4.w) * siluf_(bfhi(zc.y));
        uint2 o; o.x = pack2(o0, o1); o.y = pack2(o2, o3);
        *(uint2*)(BR + (size_t)row * 1536 + h * 64 + c4) = o;
      }
    }
    if (c + 1 < nch) { stage(Pfull, cur ^ 1); zc = Pfull.zn; }
    __syncthreads();
  };
  for (int c = 0; c < nch; c += 2) {
    body(c, P0, P1);
    if (c + 1 < nch) body(c + 1, P1, P0);
  }
#pragma unroll
  for (int r = 0; r < 2; ++r)
#pragma unroll
    for (int q = 0; q < 2; ++q)
      *(f32x4*)(st_out + (vrow0 + r) * 64 + k0 + q * 4) =
          (f32x4){S[r][2 * q].x, S[r][2 * q].y, S[r][2 * q + 1].x, S[r][2 * q + 1].y};
}

struct SsRegs { f32x4 B[4], C[4]; f32x2 sc; f32x2 x; };
__device__ __forceinline__ void ss_load(SsRegs& R, const float* vb, const float* sb, int t, int n0, int prow0) {
  const float* vt = vb + t * 320;
#pragma unroll
  for (int q = 0; q < 4; ++q) {
    R.B[q] = *(const f32x4*)(vt + n0 + q * 4);
    R.C[q] = *(const f32x4*)(vt + 128 + n0 + q * 4);
  }
  R.x = *(const f32x2*)(vt + 256 + prow0);
  R.sc = *(const f32x2*)(sb + t * 2);
}
__device__ __forceinline__ f32x2 ss_step(f32x2 (&S)[2][8], const SsRegs& R) {
  const f32x2 dA2 = splat2(R.sc.y);
  f32x2 out;
#pragma unroll
  for (int r = 0; r < 2; ++r) {
    const f32x2 xdt2 = splat2((r ? R.x.y : R.x.x) * R.sc.x);
    f32x2 y0 = splat2(0.f), y1 = splat2(0.f);
#pragma unroll
    for (int q = 0; q < 4; ++q) {
      S[r][2 * q] = S[r][2 * q] * dA2 + xdt2 * lo2(R.B[q]);
      S[r][2 * q + 1] = S[r][2 * q + 1] * dA2 + xdt2 * hi2(R.B[q]);
      y0 += S[r][2 * q] * lo2(R.C[q]);
      y1 += S[r][2 * q + 1] * hi2(R.C[q]);
    }
    y0 += y1;
    const float y = red8(y0.x + y0.y);
    if (r) out.y = y; else out.x = y;
  }
  return out;
}

__device__ __forceinline__ void scan_ssm(const Params& p, int l, int seq, int h, char* smem) {
  float* vec = (float*)smem;
  float* scb = vec + 2 * 16 * 320;
  float* yb = scb + 2 * 16 * 2;
  const int tid = otid(), lane = tid & 63, wave = tid >> 6;
  const int prow0 = wave * 16 + (lane >> 3) * 2, part = lane & 7, n0 = part * 16;
  const int g = h >> 2;
  int T, row0; const float* st_in; float* st_out;
  if (seq < 8) { T = LP; row0 = seq * LP; st_in = nullptr; st_out = p.out + O_P_SSM + (((size_t)l * 8 + seq) * 8 + h) * 8192; }
  else { const int b = seq - 8; T = 1; row0 = NTP + b;
         st_in = p.in[4] + (((size_t)l * 128 + b) * 8 + h) * 8192;
         st_out = p.out + O_S_SSM + (((size_t)l * 128 + b) * 8 + h) * 8192; }
  f32x2 S[2][8];
  if (st_in) {
#pragma unroll
    for (int r = 0; r < 2; ++r)
#pragma unroll
      for (int q = 0; q < 4; ++q) {
        const f32x4 v = *(const f32x4*)(st_in + (prow0 + r) * 128 + n0 + q * 4);
        S[r][2 * q] = lo2(v); S[r][2 * q + 1] = hi2(v);
      }
  } else {
#pragma unroll
    for (int r = 0; r < 2; ++r)
#pragma unroll
      for (int i = 0; i < 8; ++i) S[r][i] = splat2(0.f);
  }
  const bf16_t* SXBC = (const bf16_t*)(p.ws + OFF_SXBC);
  const float* SDT = (const float*)(p.ws + OFF_SDT);
  const bf16_t* POST = (const bf16_t*)(p.ws + OFF_POST);
  bf16_t* BR = (bf16_t*)(p.ws + OFF_BR);
  float* STAT = (float*)(p.ws + OFF_STAT);
  const float dskip = p.in[25][l * 8 + h];
  const int nch = (T + 15) >> 4;
  uint2 zc = make_uint2(0, 0);
  const int st_t = tid >> 4, st_j = tid & 15;

  const int tcl = (T >= 16) ? 1 : 0;
  const int oZ = (row0 + st_t * tcl) * POST_W + QC_SSMZ + h * 64 + st_j * 4;
  const int oS = (row0 + (tid & 15) * tcl) * 16 + h * 2;
  int oB[3];
#pragma unroll
  for (int i = 0; i < 3; ++i) {
    const int idx = (tid + 256 * i < 640) ? tid + 256 * i : 0;
    const int tt = idx / 40, chn = idx - tt * 40;
    int col;
    if (chn < 16) col = 512 + g * 128 + chn * 8;
    else if (chn < 32) col = 768 + g * 128 + (chn - 16) * 8;
    else col = h * 64 + (chn - 32) * 8;
    oB[i] = (row0 + tt * tcl) * 1024 + col;
  }
  auto prefetch = [&](SsP& P, int c)
  {
    const int cc = c * 16;
    P.pb[0] = *(const u32x4*)(SXBC + oB[0] + cc * 1024);
    P.pb[1] = *(const u32x4*)(SXBC + oB[1] + cc * 1024);
    if (tid < 128) P.pb[2] = *(const u32x4*)(SXBC + oB[2] + cc * 1024);
    P.zn = *(const uint2*)(POST + oZ + cc * POST_W);
    if (tid < 16) P.psc = *(const float2*)(SDT + oS + cc * 16);
  };
  int sB_[3];
#pragma unroll
  for (int i = 0; i < 3; ++i) {
    const int idx = (tid + 256 * i < 640) ? tid + 256 * i : 0;
    const int tt = idx / 40, chn = idx - tt * 40;
    sB_[i] = tt * 320 + chn * 8;
  }
  auto stage = [&](const SsP& P, int buf)
  {
    float* vb_ = vec + buf * 16 * 320;
    float4 lo, hi;
    cvt8(P.pb[0], lo, hi); *(float4*)(vb_ + sB_[0]) = lo; *(float4*)(vb_ + sB_[0] + 4) = hi;
    cvt8(P.pb[1], lo, hi); *(float4*)(vb_ + sB_[1]) = lo; *(float4*)(vb_ + sB_[1] + 4) = hi;
    if (tid < 128) { cvt8(P.pb[2], lo, hi); *(float4*)(vb_ + sB_[2]) = lo; *(float4*)(vb_ + sB_[2] + 4) = hi; }
    if (tid < 16) *(float2*)(scb + buf * 32 + tid * 2) = P.psc;
  };
  SsP P0{}, P1{};
  __syncthreads();
  prefetch(P0, 0);
  stage(P0, 0);
  zc = P0.zn;
  if (nch > 1) prefetch(P1, 1);
  __syncthreads();
  auto body = [&](int c, SsP& Pfree, const SsP& Pfull) {
    const int cur = c & 1;
    prefetch(Pfree, min(c + 2, nch - 1));
    const int nsteps = min(16, T - c * 16);
    const float* vb = vec + cur * 16 * 320;
    const float* sb = scb + cur * 32;
    SsRegs RA, RB;
    float* ydummy = yb + 16 * 64 + tid * 2;
    ss_load(RA, vb, sb, 0, n0, prow0);
    for (int t = 0; t < nsteps; t += 2) {
      ss_load(RB, vb, sb, min(t + 1, 15), n0, prow0);
      const f32x2 y0v = ss_step(S, RA);
      *(f32x2*)((part == 0) ? (yb + t * 64 + prow0) : ydummy) = y0v;
      SCAN_INTERLEAVE(10, 5);
      if (t + 1 < nsteps) {
        ss_load(RA, vb, sb, min(t + 2, 15), n0, prow0);
        const f32x2 y1v = ss_step(S, RB);
        *(f32x2*)((part == 0) ? (yb + (t + 1) * 64 + prow0) : ydummy) = y1v;
        SCAN_INTERLEAVE(10, 5);
      }
    }
    __syncthreads();
    {
      const int t = st_t, c4 = st_j * 4;
      const bool valid = t < nsteps;
      const int row = row0 + c * 16 + (valid ? t : 0);
      const float4 y = *(const float4*)(yb + t * 64 + c4);
      const float4 x = *(const float4*)(vb + t * 320 + 256 + c4);
      const float g0 = (y.x + dskip * x.x) * siluf_(bflo(zc.x));
      const float g1 = (y.y + dskip * x.y) * siluf_(bfhi(zc.x));
      const float g2 = (y.z + dskip * x.z) * siluf_(bflo(zc.y));
      const float g3 = (y.w + dskip * x.w) * siluf_(bfhi(zc.y));
      const float ssq = red16(g0 * g0 + g1 * g1 + g2 * g2 + g3 * g3);
      if (valid) {
        uint2 o; o.x = pack2(g0, g1); o.y = pack2(g2, g3);
        *(uint2*)(BR + (size_t)row * 1536 + 512 + h * 64 + c4) = o;
        if (st_j == 0) STAT[(size_t)row * 32 + h] = ssq;
      }
    }
    if (c + 1 < nch) { stage(Pfull, cur ^ 1); zc = Pfull.zn; }
    __syncthreads();
  };
  for (int c = 0; c < nch; c += 2) {
    body(c, P0, P1);
    if (c + 1 < nch) body(c + 1, P1, P0);
  }
#pragma unroll
  for (int r = 0; r < 2; ++r)
#pragma unroll
    for (int q = 0; q < 4; ++q)
      *(f32x4*)(st_out + (prow0 + r) * 128 + n0 + q * 4) =
          (f32x4){S[r][2 * q].x, S[r][2 * q].y, S[r][2 * q + 1].x, S[r][2 * q + 1].y};
}

struct GdRegs { f32x4 q[4], k[4]; f32x4 sc; float v; };
__device__ __forceinline__ void gd_load(GdRegs& R, const float* vb, const float* sb, int t, int k0, int cl) {
  const float* vt = vb + t * 288;
#pragma unroll
  for (int q = 0; q < 4; ++q) {
    R.q[q] = *(const f32x4*)(vt + k0 + q * 4);
    R.k[q] = *(const f32x4*)(vt + 128 + k0 + q * 4);
  }
  R.v = vt[256 + cl];
  R.sc = *(const f32x4*)(sb + t * 4);
}
__device__ __forceinline__ float gd_step(f32x2 (&S)[8], const GdRegs& R) {
  f32x2 k0a = splat2(0.f), k1a = splat2(0.f), q0a = splat2(0.f), q1a = splat2(0.f);
#pragma unroll
  for (int q = 0; q < 4; ++q) {
    k0a += S[2 * q] * lo2(R.k[q]);
    k1a += S[2 * q + 1] * hi2(R.k[q]);
    q0a += S[2 * q] * lo2(R.q[q]);
    q1a += S[2 * q + 1] * hi2(R.q[q]);
  }
  k0a += k1a; q0a += q1a;
  const float dK = red8(k0a.x + k0a.y), dQ = red8(q0a.x + q0a.y);
  const float vn = R.sc.y * (R.v - R.sc.x * dK);
  const float o = R.sc.x * dQ + R.sc.z * vn;
  const f32x2 al2 = splat2(R.sc.x), vn2 = splat2(vn);
#pragma unroll
  for (int q = 0; q < 4; ++q) {
    S[2 * q] = S[2 * q] * al2 + lo2(R.k[q]) * vn2;
    S[2 * q + 1] = S[2 * q + 1] * al2 + hi2(R.k[q]) * vn2;
  }
  return o;
}

__device__ __forceinline__ void scan_gdn(const Params& p, int l, int seq, int h, int qt, char* smem) {
  float* vec = (float*)smem;
  float* scb = vec + 2 * 16 * 288;
  float* yb = scb + 2 * 16 * 4;
  const int tid = otid(), lane = tid & 63, wave = tid >> 6;
  const int cl = wave * 8 + (lane >> 3), part = lane & 7, k0 = part * 16;
  const int col = qt * 32 + cl;
  int T, row0; const float* st_in; float* st_out;
  if (seq < 8) { T = LP; row0 = seq * LP; st_in = nullptr; st_out = p.out + O_P_GDN + (((size_t)l * 8 + seq) * 4 + h) * 16384; }
  else { const int b = seq - 8; T = 1; row0 = NTP + b;
         st_in = p.in[6] + (((size_t)l * 128 + b) * 4 + h) * 16384;
         st_out = p.out + O_S_GDN + (((size_t)l * 128 + b) * 4 + h) * 16384; }
  f32x2 S[8];
  if (st_in) {
#pragma unroll
    for (int i = 0; i < 8; ++i) {
      S[i].x = st_in[(size_t)(k0 + 2 * i) * 128 + col];
      S[i].y = st_in[(size_t)(k0 + 2 * i + 1) * 128 + col];
    }
  } else {
#pragma unroll
    for (int i = 0; i < 8; ++i) S[i] = splat2(0.f);
  }
  const bf16_t* GQKV = (const bf16_t*)(p.ws + OFF_GQKV);
  const float* GSC = (const float*)(p.ws + OFF_GSC);
  const bf16_t* POST = (const bf16_t*)(p.ws + OFF_POST);
  bf16_t* BR = (bf16_t*)(p.ws + OFF_BR);
  float* STAT = (float*)(p.ws + OFF_STAT);
  const int nch = (T + 15) >> 4;
  unsigned zc = 0;
  const int st_t = tid >> 4, st_j = tid & 15;

  const int tcl = (T >= 16) ? 1 : 0;
  const int oZ = (row0 + st_t * tcl) * POST_W + QC_GDNZ + h * 128 + qt * 32 + st_j * 2;
  const int oS = ((row0 + (tid & 15) * tcl) * 4 + h) * 4;
  int oB[3];
#pragma unroll
  for (int i = 0; i < 3; ++i) {
    const int idx = (tid + 256 * i < 576) ? tid + 256 * i : 0;
    const int tt = idx / 36, chn = idx - tt * 36;
    int cc_;
    if (chn < 16) cc_ = h * 128 + chn * 8;
    else if (chn < 32) cc_ = 512 + h * 128 + (chn - 16) * 8;
    else cc_ = 1024 + h * 128 + qt * 32 + (chn - 32) * 8;
    oB[i] = (row0 + tt * tcl) * 1536 + cc_;
  }
  auto prefetch = [&](GdP& P, int c)
  {
    const int cc = c * 16;
    P.pb[0] = *(const u32x4*)(GQKV + oB[0] + cc * 1536);
    P.pb[1] = *(const u32x4*)(GQKV + oB[1] + cc * 1536);
    if (tid < 64) P.pb[2] = *(const u32x4*)(GQKV + oB[2] + cc * 1536);
    P.zn = *(const unsigned*)(POST + oZ + cc * POST_W);
    if (tid < 16) P.psc = *(const float4*)(GSC + oS + cc * 16);
  };
  int sB_[3];
#pragma unroll
  for (int i = 0; i < 3; ++i) {
    const int idx = (tid + 256 * i < 576) ? tid + 256 * i : 0;
    const int tt = idx / 36, chn = idx - tt * 36;
    sB_[i] = tt * 288 + chn * 8;
  }
  auto stage = [&](const GdP& P, int buf)
  {
    float* vb_ = vec + buf * 16 * 288;
    float4 lo, hi;
    cvt8(P.pb[0], lo, hi); *(float4*)(vb_ + sB_[0]) = lo; *(float4*)(vb_ + sB_[0] + 4) = hi;
    cvt8(P.pb[1], lo, hi); *(float4*)(vb_ + sB_[1]) = lo; *(float4*)(vb_ + sB_[1] + 4) = hi;
    if (tid < 64) { cvt8(P.pb[2], lo, hi); *(float4*)(vb_ + sB_[2]) = lo; *(float4*)(vb_ + sB_[2] + 4) = hi; }
    if (tid < 16) *(float4*)(scb + buf * 64 + tid * 4) = P.psc;
  };
  GdP P0{}, P1{};
  __syncthreads();
  prefetch(P0, 0);
  stage(P0, 0);
  zc = P0.zn;
  if (nch > 1) prefetch(P1, 1);
  __syncthreads();
  auto body = [&](int c, GdP& Pfree, const GdP& Pfull) {
    const int cur = c & 1;
    prefetch(Pfree, min(c + 2, nch - 1));
    const int nsteps = min(16, T - c * 16);
    const float* vb = vec + cur * 16 * 288;
    const float* sb = scb + cur * 64;
    GdRegs RA, RB;
    float* ydummy = yb + 16 * 32 + tid;
    gd_load(RA, vb, sb, 0, k0, cl);
    for (int t = 0; t < nsteps; t += 2) {
      gd_load(RB, vb, sb, min(t + 1, 15), k0, cl);
      const float o0v = gd_step(S, RA);
      *((part == 0) ? (yb + t * 32 + cl) : ydummy) = o0v;
      SCAN_INTERLEAVE(10, 4);
      if (t + 1 < nsteps) {
        gd_load(RA, vb, sb, min(t + 2, 15), k0, cl);
        const float o1v = gd_step(S, RB);
        *((part == 0) ? (yb + (t + 1) * 32 + cl) : ydummy) = o1v;
        SCAN_INTERLEAVE(10, 4);
      }
    }
    __syncthreads();
    {
      const int t = st_t, c2 = st_j * 2;
      const bool valid = t < nsteps;
      const int row = row0 + c * 16 + (valid ? t : 0);
      const float2 o = *(const float2*)(yb + t * 32 + c2);
      const float ssq = red16(o.x * o.x + o.y * o.y);
      if (valid) {
        *(unsigned*)(BR + (size_t)row * 1536 + 1024 + h * 128 + qt * 32 + c2) =
            pack2(o.x * siluf_(bflo(zc)), o.y * siluf_(bfhi(zc)));
        if (st_j == 0) STAT[(size_t)row * 32 + 16 + h * 4 + qt] = ssq;
      }
    }
    if (c + 1 < nch) { stage(Pfull, cur ^ 1); zc = Pfull.zn; }
    __syncthreads();
  };
  for (int c = 0; c < nch; c += 2) {
    body(c, P0, P1);
    if (c + 1 < nch) body(c + 1, P1, P0);
  }
#pragma unroll
  for (int i = 0; i < 8; ++i) {
    st_out[(size_t)(k0 + 2 * i) * 128 + col] = S[i].x;
    st_out[(size_t)(k0 + 2 * i + 1) * 128 + col] = S[i].y;
  }
}

__device__ __forceinline__ void scan_item(const Params& p, int l, int idx, bool is_long, char* smem) {
  const int ns = is_long ? 8 : 128;
  const int sbase = is_long ? 0 : 8;
  const int n_rw = ns * 8, n_ss = ns * 8;
  if (idx < n_rw) { scan_rwkv(p, l, sbase + idx / 8, idx % 8, smem); return; }
  idx -= n_rw;
  if (idx < n_ss) { scan_ssm(p, l, sbase + idx / 8, idx % 8, smem); return; }
  idx -= n_ss;
  { const int s = idx / 16, r = idx % 16; scan_gdn(p, l, sbase + s, r >> 2, r & 3, smem); }
}

__device__ __forceinline__ void phase_scan(const Params& p, int l, char* smem) {
  const int G = gridDim.x, bid = blockIdx.x;
  const int nlong = 256, nshort = 4096;
  int v0, stride, limit;
  if (G >= nlong + 64) {
    if (bid < nlong) { v0 = bid; stride = G; limit = nlong; }
    else { v0 = bid; stride = G - nlong; limit = nlong + nshort; }
  } else { v0 = bid; stride = G; limit = nlong + nshort; }
  for (int v = v0; v < limit; v += stride) {
    const bool is_long = v < nlong;
    scan_item(p, l, is_long ? v : v - nlong, is_long, smem);
  }
  if (l + 1 < DEPTH) {
    const int n_in = (NPAD / 64) * 16, n_lora = 16;
    int w0, wstride;
    if (G >= nlong + 64) { w0 = (bid >= nlong) ? bid - nlong : n_in + n_lora; wstride = G - nlong; }
    else { w0 = bid; wstride = G; }
    __syncthreads();
    for (int t = w0; t < n_in + n_lora; t += wstride) {
      if (t < n_in) {
        const int nt = t >> 4, kt = t & 15;
        convert_tile<true>(p.in[10] + (size_t)(l + 1) * 1024 * DPROJ, DPROJ, nt * 64, kt * 64,
                           (bf16_t*)(p.ws + OFF_WIN), 1024, smem);
      } else {
        const int u = t - n_in;
        const int which = u >> 3, nt = u & 7;
        convert_tile<false>(p.in[which ? 15 : 13] + (size_t)(l + 1) * 64 * 512, 512, nt * 64, 0,
                            (bf16_t*)(p.ws + (which ? OFF_A2T : OFF_W2T)), 64, smem);
      }
    }
  }
}

__device__ __forceinline__ void phase_post(const Params& p, int l) {
  const int tid = otid(), lane = tid & 63, wave = tid >> 6;
  bf16_t* BR = (bf16_t*)(p.ws + OFF_BR);
  const float* STAT = (const float*)(p.ws + OFF_STAT);
  const float* snw = p.in[26] + (size_t)l * 512;
  const float* gnw = p.in[30] + (size_t)l * 128;
  for (int it = blockIdx.x; it < NT / 4; it += gridDim.x) {
    const int row = it * 4 + wave;
    float rs; const float* nw;
    if (lane < 32) {
      const int g = lane >> 4;
      const float4 a = *(const float4*)(STAT + (size_t)row * 32 + g * 4);
      const float s = (a.x + a.y) + (a.z + a.w);
      rs = rsqrtf(s * (1.f / 256.f) + 1e-5f);
      nw = snw + lane * 16;
    } else {
      const int hh = (lane - 32) >> 3;
      const float4 a = *(const float4*)(STAT + (size_t)row * 32 + 16 + hh * 4);
      const float s = (a.x + a.y) + (a.z + a.w);
      rs = rsqrtf(s * (1.f / 128.f) + 1e-6f);
      nw = gnw + ((lane - 32) & 7) * 16;
    }
    bf16_t* ptr = BR + (size_t)row * 1536 + 512 + lane * 16;
#pragma unroll
    for (int q = 0; q < 2; ++q) {
      uint4 u = *(const uint4*)(ptr + q * 8);
      const float4 w0 = *(const float4*)(nw + q * 8);
      const float4 w1 = *(const float4*)(nw + q * 8 + 4);
      u.x = pack2(bflo(u.x) * rs * w0.x, bfhi(u.x) * rs * w0.y);
      u.y = pack2(bflo(u.y) * rs * w0.z, bfhi(u.y) * rs * w0.w);
      u.z = pack2(bflo(u.z) * rs * w1.x, bfhi(u.z) * rs * w1.y);
      u.w = pack2(bflo(u.w) * rs * w1.z, bfhi(u.w) * rs * w1.w);
      *(uint4*)(ptr + q * 8) = u;
    }
  }
}

__device__ __forceinline__ void phase_gemm_merge(const Params& p, char* smem) {
  const bf16_t* BR = (const bf16_t*)(p.ws + OFF_BR);
  const bf16_t* W = (const bf16_t*)(p.ws + OFF_WBR);
  const bf16_t* POST = (const bf16_t*)(p.ws + OFF_POST);
  bf16_t* MG = (bf16_t*)(p.ws + OFF_MERGED);
  const int tid_ = otid(); const int lane = tid_ & 63, wave = tid_ >> 6;
  const int MT = NT / 130, NTn = 8;
  const int iters = tile_iters(MT, NTn);
  for (int it = 0; it < iters; ++it) {
    int mt, nt;
    if (!tile_at(it, MT, NTn, mt, nt)) break;
    f32x4 outv[9][2];
#pragma unroll
    for (int i = 0; i < 9; ++i)
#pragma unroll
      for (int j = 0; j < 2; ++j) outv[i][j] = (f32x4){0.f, 0.f, 0.f, 0.f};
    for (int b = 0; b < 3; ++b) {
      f32x4 acc[9][2];
#pragma unroll
      for (int i = 0; i < 9; ++i)
#pragma unroll
        for (int j = 0; j < 2; ++j) acc[i][j] = (f32x4){0.f, 0.f, 0.f, 0.f};
      gemm_core144(BR + (size_t)mt * 130 * 1536 + b * 512, 1536, W + ((size_t)b * 1024 + nt * 128) * 512, 512, 512, acc, smem);
#pragma unroll
      for (int i = 0; i < 9; ++i) {
        const int ml = i * 16 + (lane & 15);
        const int m = mt * 130 + min(ml, 129);
#pragma unroll
        for (int j = 0; j < 2; ++j) {
          const int n = nt * 128 + wave * 32 + j * 16 + (lane >> 4) * 4;
          const uint2 gz = *(const uint2*)(POST + (size_t)m * POST_W + QC_GATE + b * 1024 + n);
          outv[i][j][0] += sigmoidf_(bflo(gz.x)) * acc[i][j][0];
          outv[i][j][1] += sigmoidf_(bfhi(gz.x)) * acc[i][j][1];
          outv[i][j][2] += sigmoidf_(bflo(gz.y)) * acc[i][j][2];
          outv[i][j][3] += sigmoidf_(bfhi(gz.y)) * acc[i][j][3];
        }
      }
    }
#pragma unroll
    for (int i = 0; i < 9; ++i) {
      const int ml = i * 16 + (lane & 15);
      if (ml < 130) {
        const int m = mt * 130 + ml;
#pragma unroll
        for (int j = 0; j < 2; ++j) {
          const int n = nt * 128 + wave * 32 + j * 16 + (lane >> 4) * 4;
          uint2 o;
          o.x = pack2(outv[i][j][0], outv[i][j][1]);
          o.y = pack2(outv[i][j][2], outv[i][j][3]);
          *(uint2*)(MG + (size_t)m * 1024 + n) = o;
        }
      }
    }
  }
}

__device__ __forceinline__ void phase_gemm_out(const Params& p, char* smem) {
  const bf16_t* MG = (const bf16_t*)(p.ws + OFF_MERGED);
  const bf16_t* W = (const bf16_t*)(p.ws + OFF_WOUT);
  float* X = (float*)(p.ws + OFF_X);
  const int tid_ = otid(); const int lane = tid_ & 63, wave = tid_ >> 6;
  const int MT = NT / 130, NTn = 8;
  const int iters = tile_iters(MT, NTn);
  for (int it = 0; it < iters; ++it) {
    int mt, nt;
    if (!tile_at(it, MT, NTn, mt, nt)) break;
    f32x4 acc[9][2];
#pragma unroll
    for (int i = 0; i < 9; ++i)
#pragma unroll
      for (int j = 0; j < 2; ++j) acc[i][j] = (f32x4){0.f, 0.f, 0.f, 0.f};
    gemm_core144(MG + (size_t)mt * 130 * 1024, 1024, W + (size_t)nt * 128 * 1024, 1024, 1024, acc, smem);
#pragma unroll
    for (int i = 0; i < 9; ++i) {
      const int ml = i * 16 + (lane & 15);
      if (ml < 130) {
        const int m = mt * 130 + ml;
#pragma unroll
        for (int j = 0; j < 2; ++j) {
          const int n = nt * 128 + wave * 32 + j * 16 + (lane >> 4) * 4;
          float4* xp = (float4*)(X + (size_t)m * 1024 + n);
          float4 x = *xp;
          x.x += acc[i][j][0]; x.y += acc[i][j][1]; x.z += acc[i][j][2]; x.w += acc[i][j][3];
          *xp = x;
        }
      }
    }
  }
}

__device__ __forceinline__ void phase_final(const Params& p) {
  const int tid = otid(), lane = tid & 63, wave = tid >> 6;
  const float* X = (const float*)(p.ws + OFF_X);
  const float4* nw = (const float4*)p.in[35];
  for (int it = blockIdx.x; it < NT / 4; it += gridDim.x) {
    const int row = it * 4 + wave;
    float* dst;
    if (row < NTP) {
      const int b = row / LP, t = row - b * LP;
      if (t < 16) continue;
      dst = p.out + O_YP + ((size_t)b * 2048 + (t - 16)) * 1024;
    } else {
      dst = p.out + O_YS + (size_t)(row - NTP) * 1024;
    }
    const float4* src = (const float4*)(X + (size_t)row * 1024);
    float4 v[4];
    float ss = 0.f;
#pragma unroll
    for (int i = 0; i < 4; ++i) {
      v[i] = src[lane + 64 * i];
      ss += v[i].x * v[i].x + v[i].y * v[i].y + v[i].z * v[i].z + v[i].w * v[i].w;
    }
    ss = wave_sum(ss);
    const float rs = rsqrtf(ss * (1.f / 1024.f) + 1e-6f);
#pragma unroll
    for (int i = 0; i < 4; ++i) {
      const float4 w = nw[lane + 64 * i];
      ((float4*)dst)[lane + 64 * i] = make_float4(v[i].x * rs * w.x, v[i].y * rs * w.y, v[i].z * rs * w.z, v[i].w * rs * w.w);
    }
  }
}

#define XB_TMO      128
#define XB_XCNT(j)  (256  + 64 * (j))
#define XB_XSUB(j)  (1280 + 64 * (j))
#define XB_XGEN(j)  (2304 + 64 * (j))
#define XB_TOP      3328
#define XB_TOPGEN   3392
#define XCD_BAR_WORDS 3456
#define XB_SPIN_CAP (1u << 18)
#define LAS __attribute__((address_space(3)))

__device__ __forceinline__ unsigned xb_ld(unsigned* p)              { return __hip_atomic_load(p, __ATOMIC_RELAXED, __HIP_MEMORY_SCOPE_AGENT); }
__device__ __forceinline__ unsigned xb_add(unsigned* p, unsigned v) { return __hip_atomic_fetch_add(p, v, __ATOMIC_RELAXED, __HIP_MEMORY_SCOPE_AGENT); }
__device__ __forceinline__ unsigned xb_xcc_id() { return (unsigned)__builtin_amdgcn_s_getreg((3 << 11) | 20) & 0xFu; }
#define XB_SPIN(cond, bar) do { unsigned _sp = 0; while (cond) { __builtin_amdgcn_s_sleep(1); \
    if ((++_sp & 255u) == 0u) { if (xb_ld(&(bar)[XB_TMO])) break; if (_sp > XB_SPIN_CAP) { atomicAdd(&(bar)[XB_TMO], 1u); break; } } } } while (0)

struct XcdBarrier {
    unsigned* bar; unsigned x;
    volatile LAS unsigned* st;
};

__device__ __forceinline__ XcdBarrier xcd_barrier_post(unsigned* bar, volatile LAS unsigned* st) {
    XcdBarrier b; b.bar = bar; b.x = xb_xcc_id(); b.st = st;
    if (threadIdx.x == 0) (void)xb_add(&bar[XB_XCNT(b.x)], 1u);
    return b;
}
__device__ __forceinline__ void xcd_barrier_complete(unsigned* bar, unsigned x, unsigned& nloc, unsigned& nx) {
    const unsigned G = gridDim.x * gridDim.y * gridDim.z;
    unsigned sum, cnt, mine, sp = 0u;
    for (;;) {
        sum = 0u; cnt = 0u; mine = 0u;
#pragma unroll
        for (unsigned j = 0; j < 16; ++j) { const unsigned c = xb_ld(&bar[XB_XCNT(j)]); sum += c; cnt += (c > 0u) ? 1u : 0u; mine = (j == x) ? c : mine; }
        if (sum == G) break;
        __builtin_amdgcn_s_sleep(1);
        if ((++sp & 255u) == 0u) { if (xb_ld(&bar[XB_TMO])) break; if (sp > XB_SPIN_CAP) { atomicAdd(&bar[XB_TMO], 1u); break; } }
    }
    nloc = mine > 0u ? mine : 1u; nx = cnt > 0u ? cnt : 1u;
}

__device__ __forceinline__ void xcd_barrier(const XcdBarrier& b) {
    asm volatile("s_waitcnt vmcnt(0)" ::: "memory");
    __syncthreads();
    if (threadIdx.x == 0) {
        unsigned* bar = b.bar;
        __builtin_amdgcn_s_waitcnt(0);
        unsigned nloc = b.st[0], nx = b.st[1];
        if (nloc == 0u) { xcd_barrier_complete(bar, b.x, nloc, nx); b.st[0] = nloc; b.st[1] = nx; }
        const unsigned old = xb_add(&bar[XB_XSUB(b.x)], 1u);
        const unsigned gen = old / nloc;
        if (old + 1u == (gen + 1u) * nloc) {
            __builtin_amdgcn_fence(__ATOMIC_RELEASE, "agent");
            asm volatile("s_waitcnt vmcnt(0)" ::: "memory");
            const unsigned og = xb_add(&bar[XB_TOP], 1u);
            const unsigned tg = og / nx;
            if (og + 1u == (tg + 1u) * nx) xb_add(&bar[XB_TOPGEN], 1u);
            else XB_SPIN(xb_ld(&bar[XB_TOPGEN]) == tg, bar);
            __builtin_amdgcn_fence(__ATOMIC_ACQUIRE, "agent");
            xb_add(&bar[XB_XGEN(b.x)], 1u);
            asm volatile("s_waitcnt vmcnt(0)" ::: "memory");
        } else {
            XB_SPIN(xb_ld(&bar[XB_XGEN(b.x)]) == gen, bar);
            __builtin_amdgcn_fence(__ATOMIC_ACQUIRE, "agent");
            asm volatile("s_waitcnt vmcnt(0)" ::: "memory");
        }
    }
    __syncthreads();
}


constexpr int PH_PER_LAYER = 7;
constexpr int N_PHASES = DEPTH * PH_PER_LAYER + 1;

__global__ void __launch_bounds__(256, 2) mega_kernel(Params p, int ph_begin, int ph_end) {
  __shared__ __attribute__((aligned(16))) char smem[SMEM_BYTES];
  __shared__ uint4 xb_words;
  if (threadIdx.x == 0) xb_words = make_uint4(0u, 0u, 0u, 0u);
  __syncthreads();
  const XcdBarrier xb = xcd_barrier_post((unsigned*)(p.ws + OFF_BAR), (volatile LAS unsigned*)&xb_words);
  for (int ph = ph_begin; ph < ph_end; ++ph) {
    if (ph == N_PHASES - 1) {
      phase_final(p);
    } else {
      const int l = ph / PH_PER_LAYER, k = ph - l * PH_PER_LAYER;
#ifdef DOUBLE_MASK
      const int nrep = ((DOUBLE_MASK >> k) & 1) ? 2 : 1;
      for (int rep = 0; rep < nrep; ++rep)
#endif
#ifndef PHMASK
#define PHMASK 0x7f
#endif
      switch (k) {
        case 0: if (PHMASK & 1) phase_norm_convert(p, l, smem); break;
        case 1: if (PHMASK & 2) phase_gemm_in(p, smem); break;
        case 2: if (PHMASK & 4) phase_prep(p, l, smem); break;
        case 3: if (PHMASK & 8) phase_scan(p, l, smem); break;
        case 4: if (PHMASK & 16) phase_post(p, l); break;
        case 5: if (PHMASK & 32) phase_gemm_merge(p, smem); break;
        default: if (PHMASK & 64) phase_gemm_out(p, smem); break;
      }
    }
    if (ph + 1 < ph_end) {
      if (ph == ph_begin) cg::this_grid().sync();
      else xcd_barrier(xb);
    }
  }
}

extern "C" void kernel_launch(void* const* d_in, const int* in_sizes, int n_in, void* d_out, int out_size, void* d_ws,
                              size_t ws_size, hipStream_t stream) {
  if (n_in < 36 || ws_size < WS_NEED || (size_t)out_size < O_TOTAL) {
    fprintf(stderr, "kernel_launch: unexpected sizes n_in=%d ws=%zu need=%zu out=%d\n", n_in, ws_size, WS_NEED, out_size);
    return;
  }
  static int grid_blocks = 0;
  if (!grid_blocks) {
    int dev = 0, cus = 0, per_cu = 0;
    hipGetDevice(&dev);
    hipDeviceGetAttribute(&cus, hipDeviceAttributeMultiprocessorCount, dev);
    hipOccupancyMaxActiveBlocksPerMultiprocessor(&per_cu, mega_kernel, 256, 0);
    if (per_cu > 2) per_cu = 2;
    if (per_cu < 1) per_cu = 1;
    grid_blocks = cus * per_cu;
  }
  Params p{};
  for (int i = 0; i < 36; ++i) p.in[i] = (const float*)d_in[i];
  p.out = (float*)d_out;
  p.ws = (char*)d_ws;
  (void)hipMemsetAsync((char*)d_ws + OFF_BAR, 0, BAR_BYTES, stream);
#if MULTI_LAUNCH
  for (int ph = 0; ph < N_PHASES; ++ph) {
    hipLaunchKernelGGL(mega_kernel, dim3(grid_blocks), dim3(256), 0, stream, p, ph, ph + 1);
  }
#else
  int b = 0, e = N_PHASES;
  void* args[] = {&p, &b, &e};
  hipError_t err = hipLaunchCooperativeKernel((void*)mega_kernel, dim3(grid_blocks), dim3(256), args, 0, stream);
  if (err != hipSuccess) fprintf(stderr, "cooperative launch failed: %s (grid %d)\n", hipGetErrorString(err), grid_blocks);
#endif
}
```

```cpp
#include <hip/hip_runtime.h>
#include <hip/hip_cooperative_groups.h>
#include <cstdio>
namespace cg = cooperative_groups;

#ifndef MULTI_LAUNCH
#define MULTI_LAUNCH 0
#endif

typedef unsigned short bf16_t;
using bf16x8 = __attribute__((ext_vector_type(8))) short;
using f32x4 = __attribute__((ext_vector_type(4))) float;
using u32x4 = __attribute__((ext_vector_type(4))) unsigned;

constexpr int DM = 1024;
constexpr int LP = 2064;
constexpr int NTP = 8 * LP;
constexpr int NT = NTP + 128;
constexpr int DEPTH = 4;
constexpr int DPROJ = 8848;
constexpr int PRE_W = 4352;
constexpr int POST_W = 4608;
constexpr int NPAD = PRE_W + POST_W;
constexpr int PC_RW = 0, PC_XBC = 1664, PC_QKV = 2688, PC_DT = 4224, PC_GA = 4232, PC_GB = 4236;
constexpr int QC_RWZ = 0, QC_SSMZ = 512, QC_GDNZ = 1024, QC_GATE = 1536;

constexpr size_t SZ_X = (size_t)NT * 1024 * 4;
constexpr size_t SZ_PRE = (size_t)NT * PRE_W * 2;
constexpr size_t SZ_POST = (size_t)NT * POST_W * 2;
constexpr size_t OFF_X = 0;
constexpr size_t OFF_PRE = OFF_X + SZ_X;
constexpr size_t OFF_POST = OFF_PRE + SZ_PRE;
constexpr size_t OFF_SCAN = OFF_POST + SZ_POST;
constexpr size_t OFF_RWW = OFF_SCAN;
constexpr size_t OFF_RW5 = OFF_RWW + (size_t)NT * 512 * 4;
constexpr size_t OFF_RWSC = OFF_RW5 + (size_t)NT * 5 * 512 * 2;
constexpr size_t OFF_SXBC = OFF_RWSC + (size_t)NT * 32 * 4;
constexpr size_t OFF_SDT = OFF_SXBC + (size_t)NT * 1024 * 2;
constexpr size_t OFF_GQKV = OFF_SDT + (size_t)NT * 16 * 4;
constexpr size_t OFF_GSC = OFF_GQKV + (size_t)NT * 1536 * 2;
constexpr size_t OFF_STAT = OFF_GSC + (size_t)NT * 16 * 4;
constexpr size_t OFF_WIN = OFF_STAT + (size_t)NT * 32 * 4;
constexpr size_t OFF_WBR = OFF_WIN + (size_t)NPAD * 1024 * 2;
constexpr size_t OFF_WOUT = OFF_WBR + (size_t)3 * 1024 * 512 * 2;
constexpr size_t OFF_W2T = OFF_WOUT + (size_t)1024 * 1024 * 2;
constexpr size_t OFF_A2T = OFF_W2T + (size_t)512 * 64 * 2;
constexpr size_t OFF_BAR = OFF_A2T + (size_t)512 * 64 * 2;
constexpr size_t BAR_BYTES = 3456 * 4;
constexpr size_t WS_NEED = OFF_BAR + 16384;
constexpr size_t OFF_H = OFF_SCAN;
constexpr size_t OFF_BR = OFF_PRE;
constexpr size_t OFF_MERGED = OFF_PRE + (size_t)NT * 1536 * 2;

constexpr size_t O_YP = 0;
constexpr size_t O_YS = O_YP + (size_t)8 * 2048 * 1024;
constexpr size_t O_P_WKV = O_YS + (size_t)128 * 1024;
constexpr size_t O_P_SHIFT = O_P_WKV + (size_t)4 * 8 * 8 * 64 * 64;
constexpr size_t O_P_SSM = O_P_SHIFT + (size_t)4 * 8 * 1664;
constexpr size_t O_P_SCONV = O_P_SSM + (size_t)4 * 8 * 8 * 64 * 128;
constexpr size_t O_P_GDN = O_P_SCONV + (size_t)4 * 8 * 3 * 1024;
constexpr size_t O_P_GCONV = O_P_GDN + (size_t)4 * 8 * 4 * 128 * 128;
constexpr size_t O_S_WKV = O_P_GCONV + (size_t)4 * 8 * 3 * 1536;
constexpr size_t O_S_SHIFT = O_S_WKV + (size_t)4 * 128 * 8 * 64 * 64;
constexpr size_t O_S_SSM = O_S_SHIFT + (size_t)4 * 128 * 1664;
constexpr size_t O_S_SCONV = O_S_SSM + (size_t)4 * 128 * 8 * 64 * 128;
constexpr size_t O_S_GDN = O_S_SCONV + (size_t)4 * 128 * 3 * 1024;
constexpr size_t O_S_GCONV = O_S_GDN + (size_t)4 * 128 * 4 * 128 * 128;
constexpr size_t O_TOTAL = O_S_GCONV + (size_t)4 * 128 * 3 * 1536;

constexpr int SMEM_BYTES = 73728;
constexpr int LDS_STRIDE = 64;

struct Params {
  const float* in[36];
  float* out;
  char* ws;
};

__device__ __forceinline__ bf16_t f2bf(float f) {
  unsigned u = __float_as_uint(f);
  u += 0x7fffu + ((u >> 16) & 1u);
  return (bf16_t)(u >> 16);
}
__device__ __forceinline__ float bf2f(bf16_t h) { return __uint_as_float(((unsigned)h) << 16); }
__device__ __forceinline__ unsigned pack2(float a, float b) { return (unsigned)f2bf(a) | ((unsigned)f2bf(b) << 16); }
__device__ __forceinline__ float bflo(unsigned u) { return __uint_as_float(u << 16); }
__device__ __forceinline__ float bfhi(unsigned u) { return __uint_as_float(u & 0xffff0000u); }
__device__ __forceinline__ float rbf(float f) { return bf2f(f2bf(f)); }

__device__ __forceinline__ int otid() { int t = threadIdx.x; asm volatile("" : "+v"(t)); return t; }
template <int CTRL>
__device__ __forceinline__ float dppf(float v) {
  return __int_as_float(__builtin_amdgcn_update_dpp(0, __float_as_int(v), CTRL, 0xF, 0xF, true));
}
__device__ __forceinline__ float red4(float v) { v += dppf<0xB1>(v); v += dppf<0x4E>(v); return v; }
__device__ __forceinline__ float red8(float v) { v = red4(v); v += dppf<0x141>(v); return v; }
__device__ __forceinline__ float red16(float v) { v = red8(v); v += dppf<0x140>(v); return v; }
__device__ __forceinline__ float wave_sum(float v) {
  v = red16(v);
  const int iv = __float_as_int(v);
  const float r0 = __int_as_float(__builtin_amdgcn_readlane(iv, 0));
  const float r1 = __int_as_float(__builtin_amdgcn_readlane(iv, 16));
  const float r2 = __int_as_float(__builtin_amdgcn_readlane(iv, 32));
  const float r3 = __int_as_float(__builtin_amdgcn_readlane(iv, 48));
  return (r0 + r1) + (r2 + r3);
}
__device__ __forceinline__ float frcp_(float x) { return __builtin_amdgcn_rcpf(x); }
__device__ __forceinline__ float sigmoidf_(float x) { return frcp_(1.f + __expf(-x)); }
__device__ __forceinline__ float siluf_(float x) { return x * frcp_(1.f + __expf(-x)); }
__device__ __forceinline__ float softplusf_(float x) { return fmaxf(x, 0.f) + __logf(1.f + __expf(-fabsf(x))); }
__device__ __forceinline__ float ftanh_(float x) {
  const float e = __expf(-2.f * fabsf(x));
  const float t = (1.f - e) * frcp_(1.f + e);
  return x < 0.f ? -t : t;
}

__device__ __forceinline__ void row_to_seq(int row, int& seq, int& t) {
  if (row < NTP) { seq = row / LP; t = row - seq * LP; } else { seq = 8 + (row - NTP); t = 0; }
}

__device__ __forceinline__ bool tile_at(int it, int MT, int NTn, int& mt, int& nt) {
  const int G = gridDim.x;
  const int nx = (G % 8 == 0) ? 8 : 1;
  const int x = blockIdx.x % nx, j = blockIdx.x / nx, nloc = G / nx;
  const int ch = x + nx * it;
  const int q = ch * nloc + j;
  if (q >= MT * NTn) return false;
  const int gs = 8 * NTn;
  const int g = q / gs, rem = q - g * gs;
  const int gsz = min(8, MT - g * 8);
  nt = rem / gsz;
  mt = g * 8 + (rem - nt * gsz);
  return true;
}
__device__ __forceinline__ int tile_iters(int MT, int NTn) {
  const int G = gridDim.x;
  const int nx = (G % 8 == 0) ? 8 : 1;
  const int nloc = G / nx;
  const int nchunks = (MT * NTn + nloc - 1) / nloc;
  return (nchunks + nx - 1) / nx;
}

__device__ __forceinline__ void mma_ktile(const bf16_t* cA, const bf16_t* cB, int fo0, int fo1, f32x4 (&acc)[4][4]) {
#pragma unroll
  for (int ks = 0; ks < 2; ++ks) {
    const int fo = ks ? fo1 : fo0;
    bf16x8 af[4], bfr[4];
#pragma unroll
    for (int i = 0; i < 4; ++i) af[i] = *(const bf16x8*)(cA + i * 16 * LDS_STRIDE + fo);
#pragma unroll
    for (int j = 0; j < 4; ++j) bfr[j] = *(const bf16x8*)(cB + j * 16 * LDS_STRIDE + fo);
#pragma unroll
    for (int i = 0; i < 4; ++i)
#pragma unroll
      for (int j = 0; j < 4; ++j)
        acc[i][j] = __builtin_amdgcn_mfma_f32_16x16x32_bf16(bfr[j], af[i], acc[i][j], 0, 0, 0);
  }
}

template <bool DEEP>
__device__ __forceinline__ void gemm_core(const bf16_t* __restrict__ A, int lda, const bf16_t* __restrict__ Bt, int ldb,
                                          int K, f32x4 (&acc)[4][4], char* smem) {
  bf16_t* sA = (bf16_t*)smem;
  bf16_t* sB = sA + 2 * 128 * LDS_STRIDE;
  const int tid = otid(), lane = tid & 63, wave = tid >> 6;
  const int wm = wave >> 1, wn = wave & 1;
  const int lr = tid >> 3, lc = (tid & 7) * 8;
  const bf16_t* ap = A + (size_t)lr * lda + lc;
  const bf16_t* bp = Bt + (size_t)lr * ldb + lc;
  const int nk = K >> 6;
  const int fr = lane & 15, fq = (lane >> 4) * 8;
  const int rswz = (fr >> 1) & 7, wswz = (lr >> 1) & 7;
  const int fo0 = (((lane >> 4)) ^ rswz) * 8, fo1 = ((4 + (lane >> 4)) ^ rswz) * 8;
  const bf16_t* cA0 = sA + (wm * 64 + fr) * LDS_STRIDE;
  const bf16_t* cB0 = sB + (wn * 64 + fr) * LDS_STRIDE;
  bf16_t* wA = sA + lr * LDS_STRIDE + (((tid & 7) ^ wswz) * 8);
  bf16_t* wB = sB + lr * LDS_STRIDE + (((tid & 7) ^ wswz) * 8);
  constexpr int BUF = 128 * LDS_STRIDE;
#define GLOAD(RA, RB, kt_)                                                         \
  _Pragma("unroll") for (int i = 0; i < 4; ++i) {                                  \
    RA[i] = *(const u32x4*)(ap + (size_t)(32 * i) * lda + ((kt_) << 6));           \
    RB[i] = *(const u32x4*)(bp + (size_t)(32 * i) * ldb + ((kt_) << 6));           \
  }
#define SWRITE(RA, RB, buf_)                                                       \
  _Pragma("unroll") for (int i = 0; i < 4; ++i) {                                  \
    *(u32x4*)(wA + (buf_) * BUF + 32 * i * LDS_STRIDE) = RA[i];                    \
    *(u32x4*)(wB + (buf_) * BUF + 32 * i * LDS_STRIDE) = RB[i];                    \
  }
  u32x4 ra0[4], rb0[4];
  GLOAD(ra0, rb0, 0);
  if (DEEP) {
    u32x4 ra1[4], rb1[4];
    GLOAD(ra1, rb1, 1);
    __syncthreads();
    SWRITE(ra0, rb0, 0);
    __syncthreads();
    for (int kt = 0; kt < nk; kt += 2) {
      { const int k2 = min(kt + 2, nk - 1); GLOAD(ra0, rb0, k2); }
      mma_ktile(cA0, cB0, fo0, fo1, acc);
      SWRITE(ra1, rb1, 1);
      __syncthreads();
      { const int k3 = min(kt + 3, nk - 1); GLOAD(ra1, rb1, k3); }
      mma_ktile(cA0 + BUF, cB0 + BUF, fo0, fo1, acc);
      if (kt + 2 < nk) { SWRITE(ra0, rb0, 0); }
      __syncthreads();
    }
  } else {
    __syncthreads();
    SWRITE(ra0, rb0, 0);
    __syncthreads();
    for (int kt = 0; kt < nk; ++kt) {
      const int cur = kt & 1;
      { const int k1 = min(kt + 1, nk - 1); GLOAD(ra0, rb0, k1); }
      mma_ktile(cA0 + cur * BUF, cB0 + cur * BUF, fo0, fo1, acc);
      if (kt + 1 < nk) { SWRITE(ra0, rb0, cur ^ 1); }
      __syncthreads();
    }
  }
#undef GLOAD
#undef SWRITE
}

__device__ __forceinline__ void gemm_core_big(const bf16_t* __restrict__ A, int lda, const bf16_t* __restrict__ Bt, int ldb,
                                              int K, f32x4 (&acc)[8][4], char* smem) {
  bf16_t* sA = (bf16_t*)smem;
  bf16_t* sB = sA + 256 * LDS_STRIDE;
  const int tid = otid(), lane = tid & 63, wave = tid >> 6;
  const int wm = wave >> 1, wn = wave & 1;
  const int lr = tid >> 3, lc = (tid & 7) * 8;
  const bf16_t* ap = A + (size_t)lr * lda + lc;
  const bf16_t* bp = Bt + (size_t)lr * ldb + lc;
  const int nk = K >> 6;
  const int fr = lane & 15, fq = (lane >> 4) * 8;
  const int rswz = (fr >> 1) & 7, wswz = (lr >> 1) & 7;
  const int fo0 = (((lane >> 4)) ^ rswz) * 8, fo1 = ((4 + (lane >> 4)) ^ rswz) * 8;
  const bf16_t* cA = sA + (wm * 128 + fr) * LDS_STRIDE;
  const bf16_t* cB = sB + (wn * 64 + fr) * LDS_STRIDE;
  bf16_t* wA = sA + lr * LDS_STRIDE + (((tid & 7) ^ wswz) * 8);
  bf16_t* wB = sB + lr * LDS_STRIDE + (((tid & 7) ^ wswz) * 8);
  u32x4 ra[8], rb[4];
#pragma unroll
  for (int i = 0; i < 8; ++i) ra[i] = *(const u32x4*)(ap + (size_t)(32 * i) * lda);
#pragma unroll
  for (int i = 0; i < 4; ++i) rb[i] = *(const u32x4*)(bp + (size_t)(32 * i) * ldb);
  for (int kt = 0; kt < nk; ++kt) {
    __syncthreads();
#pragma unroll
    for (int i = 0; i < 8; ++i) *(u32x4*)(wA + 32 * i * LDS_STRIDE) = ra[i];
#pragma unroll
    for (int i = 0; i < 4; ++i) *(u32x4*)(wB + 32 * i * LDS_STRIDE) = rb[i];
    __syncthreads();
    {
      const int k1 = min(kt + 1, nk - 1) << 6;
#pragma unroll
      for (int i = 0; i < 8; ++i) ra[i] = *(const u32x4*)(ap + (size_t)(32 * i) * lda + k1);
#pragma unroll
      for (int i = 0; i < 4; ++i) rb[i] = *(const u32x4*)(bp + (size_t)(32 * i) * ldb + k1);
    }
#pragma unroll
    for (int ks = 0; ks < 2; ++ks) {
      const int fo = ks ? fo1 : fo0;
      bf16x8 bfr[4];
#pragma unroll
      for (int j = 0; j < 4; ++j) bfr[j] = *(const bf16x8*)(cB + j * 16 * LDS_STRIDE + fo);
#pragma unroll
      for (int i = 0; i < 8; ++i) {
        const bf16x8 af = *(const bf16x8*)(cA + i * 16 * LDS_STRIDE + fo);
#pragma unroll
        for (int j = 0; j < 4; ++j)
          acc[i][j] = __builtin_amdgcn_mfma_f32_16x16x32_bf16(bfr[j], af, acc[i][j], 0, 0, 0);
      }
    }
  }
}

__device__ __forceinline__ int inproj_src_col(int np) {
  if (np < PRE_W) {
    if (np < 1664) return np;
    if (np < 2688) return np - 1664 + 2688;
    if (np < 4224) return np - 2688 + 3720;
    if (np < 4232) return np - 4224 + 3712;
    if (np < 4240) return np - 4232 + 5768;
    return -1;
  }
  const int j = np - PRE_W;
  if (j < 512) return 1664 + j;
  if (j < 1024) return 2176 + (j - 512);
  if (j < 1536) return 5256 + (j - 1024);
  return 5776 + (j - 1536);
}

template <bool INPROJ>
__device__ __forceinline__ void convert_tile(const float* __restrict__ src, int src_ld, int n0, int k0,
                                             bf16_t* __restrict__ dst, int dst_ld, char* smem) {
  float* tile = (float*)smem;
  const int tid = otid();
  const int nn = tid & 63;
  int sc = INPROJ ? inproj_src_col(n0 + nn) : (n0 + nn);
#pragma unroll
  for (int i = 0; i < 16; ++i) {
    const int kk = (tid >> 6) + 4 * i;
    float v = 0.f;
    if (sc >= 0) v = src[(size_t)(k0 + kk) * src_ld + sc];
    tile[kk * 65 + nn] = v;
  }
  __syncthreads();
#pragma unroll
  for (int i = 0; i < 8; ++i) {
    const int n2 = (tid >> 5) + 8 * i;
    const int k2 = (tid & 31) * 2;
    const unsigned pk = pack2(tile[k2 * 65 + n2], tile[(k2 + 1) * 65 + n2]);
    *(unsigned*)(dst + (size_t)(n0 + n2) * dst_ld + k0 + k2) = pk;
  }
  __syncthreads();
}

__device__ __forceinline__ void phase_norm_convert(const Params& p, int l, char* smem) {
  const int tid = otid(), lane = tid & 63, wave = tid >> 6;
  float* X = (float*)(p.ws + OFF_X);
  bf16_t* H = (bf16_t*)(p.ws + OFF_H);
  const int n_row_items = NT / 4;
  const int n_in = (NPAD / 64) * 16, n_br = 3 * 16 * 8, n_out = 16 * 16;
  const int n_lora = 16;
  const int total = n_row_items + n_in + n_br + n_out + n_lora;
  for (int it = blockIdx.x; it < total; it += gridDim.x) {
    if (it < n_row_items) {
      const int row = it * 4 + wave;
      const float* src;
      if (l == 0) {
        if (row < NTP) {
          const int b = row / LP, t = row - b * LP;
          src = (t < 16) ? (p.in[8] + (size_t)t * 1024) : (p.in[0] + ((size_t)b * 2048 + (t - 16)) * 1024);
        } else {
          src = p.in[1] + (size_t)(row - NTP) * 1024;
        }
      } else {
        src = X + (size_t)row * 1024;
      }
      float4 v[4];
      float ss = 0.f;
#pragma unroll
      for (int i = 0; i < 4; ++i) {
        v[i] = ((const float4*)src)[lane + 64 * i];
        ss += v[i].x * v[i].x + v[i].y * v[i].y + v[i].z * v[i].z + v[i].w * v[i].w;
      }
      ss = wave_sum(ss);
      const float rs = rsqrtf(ss * (1.f / 1024.f) + 1e-6f);
      const float4* nw = (const float4*)(p.in[9] + (size_t)l * 1024);
#pragma unroll
      for (int i = 0; i < 4; ++i) {
        if (l == 0) ((float4*)(X + (size_t)row * 1024))[lane + 64 * i] = v[i];
        const float4 w = nw[lane + 64 * i];
        uint2 o;
        o.x = pack2(v[i].x * rs * w.x, v[i].y * rs * w.y);
        o.y = pack2(v[i].z * rs * w.z, v[i].w * rs * w.w);
        *(uint2*)(H + (size_t)row * 1024 + (lane + 64 * i) * 4) = o;
      }
    } else {
      int t = it - n_row_items;
      if (t < n_in) {
        if (l == 0) {
          const int nt = t >> 4, kt = t & 15;
          convert_tile<true>(p.in[10] + (size_t)l * 1024 * DPROJ, DPROJ, nt * 64, kt * 64,
                             (bf16_t*)(p.ws + OFF_WIN), 1024, smem);
        }
      } else if (t < n_in + n_br) {
        t -= n_in;
        const int b = t / 128, r = t - b * 128;
        const int nt = r >> 3, kt = r & 7;
        convert_tile<false>(p.in[31 + b] + (size_t)l * 512 * 1024, 1024, nt * 64, kt * 64,
                            (bf16_t*)(p.ws + OFF_WBR) + (size_t)b * 1024 * 512, 512, smem);
      } else if (t < n_in + n_br + n_out) {
        t -= n_in + n_br;
        const int nt = t >> 4, kt = t & 15;
        convert_tile<false>(p.in[34] + (size_t)l * 1024 * 1024, 1024, nt * 64, kt * 64,
                            (bf16_t*)(p.ws + OFF_WOUT), 1024, smem);
      } else {
        t -= n_in + n_br + n_out;
        if (l == 0) {
          const int which = t >> 3, nt = t & 7;
          convert_tile<false>(p.in[which ? 15 : 13] + (size_t)l * 64 * 512, 512, nt * 64, 0,
                              (bf16_t*)(p.ws + (which ? OFF_A2T : OFF_W2T)), 64, smem);
        }
      }
    }
  }
}

__device__ __forceinline__ void phase_gemm_in(const Params& p, char* smem) {
  const bf16_t* H = (const bf16_t*)(p.ws + OFF_H);
  const bf16_t* W = (const bf16_t*)(p.ws + OFF_WIN);
  bf16_t* PRE = (bf16_t*)(p.ws + OFF_PRE);
  bf16_t* POST = (bf16_t*)(p.ws + OFF_POST);
  const int tid_ = otid(); const int lane = tid_ & 63, wave = tid_ >> 6, wm = wave >> 1, wn = wave & 1;
  const int MT = NT / 256, NTn = NPAD / 128;
  const int iters = tile_iters(MT, NTn);
  for (int it = 0; it < iters; ++it) {
    int mt, nt;
    if (!tile_at(it, MT, NTn, mt, nt)) break;
    f32x4 acc[8][4];
#pragma unroll
    for (int i = 0; i < 8; ++i)
#pragma unroll
      for (int j = 0; j < 4; ++j) acc[i][j] = (f32x4){0.f, 0.f, 0.f, 0.f};
    gemm_core_big(H + (size_t)mt * 256 * 1024, 1024, W + (size_t)nt * 128 * 1024, 1024, 1024, acc, smem);
    bf16_t* dst; int ldd, ncol0;
    if (nt < PRE_W / 128) { dst = PRE; ldd = PRE_W; ncol0 = nt * 128; }
    else { dst = POST; ldd = POST_W; ncol0 = (nt - PRE_W / 128) * 128; }
#pragma unroll
    for (int i = 0; i < 8; ++i) {
      const int m = mt * 256 + wm * 128 + i * 16 + (lane & 15);
#pragma unroll
      for (int j = 0; j < 4; ++j) {
        const int n = ncol0 + wn * 64 + j * 16 + (lane >> 4) * 4;
        uint2 o;
        o.x = pack2(acc[i][j][0], acc[i][j][1]);
        o.y = pack2(acc[i][j][2], acc[i][j][3]);
        *(uint2*)(dst + (size_t)m * ldd + n) = o;
      }
    }
  }
}

__device__ __forceinline__ void prep_rwkv(const Params& p, int l, int item, char* smem) {
  bf16_t* sA = (bf16_t*)smem;
  float* sW = (float*)(smem + 4352);
  float* sAs = sW + 16 * 516;
  const int tid = otid(), lane = tid & 63, wave = tid >> 6;
  const int row0 = item * 16;
  const bf16_t* PRE = (const bf16_t*)(p.ws + OFF_PRE);
  const float* mu = p.in[11] + (size_t)l * 1664;
  const float* shift_in = p.in[3] + (size_t)l * 128 * 1664;
  float* RWW = (float*)(p.ws + OFF_RWW);
  bf16_t* RW5 = (bf16_t*)(p.ws + OFF_RW5);
  float* RWSC = (float*)(p.ws + OFF_RWSC);
  const bf16_t* W2T = (const bf16_t*)(p.ws + OFF_W2T);
  const bf16_t* A2T = (const bf16_t*)(p.ws + OFF_A2T);

  __syncthreads();
  {
    const int tok = tid >> 4, c8 = (tid & 15) * 8;
    const int row = row0 + tok;
    int seq, t; row_to_seq(row, seq, t);
    const int col = 1536 + c8;
    const u32x4 pv = *(const u32x4*)(PRE + (size_t)row * PRE_W + col);
    float x[8], pr[8];
    x[0] = bflo(pv.x); x[1] = bfhi(pv.x); x[2] = bflo(pv.y); x[3] = bfhi(pv.y);
    x[4] = bflo(pv.z); x[5] = bfhi(pv.z); x[6] = bflo(pv.w); x[7] = bfhi(pv.w);
    if (t > 0) {
      const u32x4 pp = *(const u32x4*)(PRE + (size_t)(row - 1) * PRE_W + col);
      pr[0] = bflo(pp.x); pr[1] = bfhi(pp.x); pr[2] = bflo(pp.y); pr[3] = bfhi(pp.y);
      pr[4] = bflo(pp.z); pr[5] = bfhi(pp.z); pr[6] = bflo(pp.w); pr[7] = bfhi(pp.w);
    } else if (seq >= 8) {
      const float4 h0 = *(const float4*)(shift_in + (size_t)(seq - 8) * 1664 + col);
      const float4 h1 = *(const float4*)(shift_in + (size_t)(seq - 8) * 1664 + col + 4);
      pr[0] = h0.x; pr[1] = h0.y; pr[2] = h0.z; pr[3] = h0.w; pr[4] = h1.x; pr[5] = h1.y; pr[6] = h1.z; pr[7] = h1.w;
    } else {
#pragma unroll
      for (int j = 0; j < 8; ++j) pr[j] = 0.f;
    }
    const float4 m0 = *(const float4*)(mu + col), m1 = *(const float4*)(mu + col + 4);
    const float mm[8] = {m0.x, m0.y, m0.z, m0.w, m1.x, m1.y, m1.z, m1.w};
    float u[8];
#pragma unroll
    for (int j = 0; j < 8; ++j) {
      u[j] = x[j] + (pr[j] - x[j]) * mm[j];
      if (c8 < 64) u[j] = ftanh_(u[j]);
    }
    u32x4 o;
    o.x = pack2(u[0], u[1]); o.y = pack2(u[2], u[3]); o.z = pack2(u[4], u[5]); o.w = pack2(u[6], u[7]);
    *(u32x4*)(sA + tok * 136 + c8) = o;
  }
  __syncthreads();
  {
    const int fr = lane & 15, fq = (lane >> 4) * 8;
    bf16x8 atw[2], aad[2];
#pragma unroll
    for (int ks = 0; ks < 2; ++ks) {
      atw[ks] = *(const bf16x8*)(sA + fr * 136 + ks * 32 + fq);
      aad[ks] = *(const bf16x8*)(sA + fr * 136 + 64 + ks * 32 + fq);
    }
    const float* w0 = p.in[12] + (size_t)l * 512;
    const float* a0 = p.in[14] + (size_t)l * 512;
#pragma unroll
    for (int jt = 0; jt < 8; ++jt) {
      const int n = wave * 128 + jt * 16 + fr;
      f32x4 cw = (f32x4){0.f, 0.f, 0.f, 0.f}, ca = (f32x4){0.f, 0.f, 0.f, 0.f};
#pragma unroll
      for (int ks = 0; ks < 2; ++ks) {
        const bf16x8 bw = *(const bf16x8*)(W2T + (size_t)n * 64 + ks * 32 + fq);
        const bf16x8 ba = *(const bf16x8*)(A2T + (size_t)n * 64 + ks * 32 + fq);
        cw = __builtin_amdgcn_mfma_f32_16x16x32_bf16(atw[ks], bw, cw, 0, 0, 0);
        ca = __builtin_amdgcn_mfma_f32_16x16x32_bf16(aad[ks], ba, ca, 0, 0, 0);
      }
      const float w0v = w0[n], a0v = a0[n];
#pragma unroll
      for (int r = 0; r < 4; ++r) {
        const int tok = (lane >> 4) * 4 + r;
        const float wl = w0v + cw[r];
        const float wv = -softplusf_(-wl) - 0.5f;
        sW[tok * 516 + n] = __expf(-__expf(wv));
        sAs[tok * 516 + n] = sigmoidf_(a0v + ca[r]);
      }
    }
  }
  __syncthreads();
  {
    const int chunk = tid & 127, ch4 = chunk * 4, head = chunk >> 4;
    const float4 mur = *(const float4*)(mu + ch4), muk = *(const float4*)(mu + 512 + ch4), muv = *(const float4*)(mu + 1024 + ch4);
    const float4 kkc = *(const float4*)(p.in[16] + (size_t)l * 512 + ch4);
    const float4 kac = *(const float4*)(p.in[17] + (size_t)l * 512 + ch4);
    const float4 rkc = *(const float4*)(p.in[18] + (size_t)l * 512 + ch4);
#pragma unroll
    for (int i = 0; i < 8; ++i) {
      const int tok = (tid >> 7) + 2 * i;
      const int row = row0 + tok;
      int seq, t; row_to_seq(row, seq, t);
      const uint2 pr_ = *(const uint2*)(PRE + (size_t)row * PRE_W + ch4);
      const uint2 pk_ = *(const uint2*)(PRE + (size_t)row * PRE_W + 512 + ch4);
      const uint2 pv_ = *(const uint2*)(PRE + (size_t)row * PRE_W + 1024 + ch4);
      float4 qr, qk, qv;
      if (t > 0) {
        const uint2 a_ = *(const uint2*)(PRE + (size_t)(row - 1) * PRE_W + ch4);
        const uint2 b_ = *(const uint2*)(PRE + (size_t)(row - 1) * PRE_W + 512 + ch4);
        const uint2 c_ = *(const uint2*)(PRE + (size_t)(row - 1) * PRE_W + 1024 + ch4);
        qr = make_float4(bflo(a_.x), bfhi(a_.x), bflo(a_.y), bfhi(a_.y));
        qk = make_float4(bflo(b_.x), bfhi(b_.x), bflo(b_.y), bfhi(b_.y));
        qv = make_float4(bflo(c_.x), bfhi(c_.x), bflo(c_.y), bfhi(c_.y));
      } else if (seq >= 8) {
        const float* sh = shift_in + (size_t)(seq - 8) * 1664;
        qr = *(const float4*)(sh + ch4); qk = *(const float4*)(sh + 512 + ch4); qv = *(const float4*)(sh + 1024 + ch4);
      } else {
        qr = qk = qv = make_float4(0.f, 0.f, 0.f, 0.f);
      }
      const float4 dec = *(const float4*)(sW + tok * 516 + ch4);
      const float4 as = *(const float4*)(sAs + tok * 516 + ch4);
      const float pr4[4] = {bflo(pr_.x), bfhi(pr_.x), bflo(pr_.y), bfhi(pr_.y)};
      const float pk4[4] = {bflo(pk_.x), bfhi(pk_.x), bflo(pk_.y), bfhi(pk_.y)};
      const float pv4[4] = {bflo(pv_.x), bfhi(pv_.x), bflo(pv_.y), bfhi(pv_.y)};
      const float qr4[4] = {qr.x, qr.y, qr.z, qr.w}, qk4[4] = {qk.x, qk.y, qk.z, qk.w}, qv4[4] = {qv.x, qv.y, qv.z, qv.w};
      const float mr4[4] = {mur.x, mur.y, mur.z, mur.w}, mk4[4] = {muk.x, muk.y, muk.z, muk.w}, mv4[4] = {muv.x, muv.y, muv.z, muv.w};
      const float kk4[4] = {kkc.x, kkc.y, kkc.z, kkc.w}, ka4[4] = {kac.x, kac.y, kac.z, kac.w}, rk4[4] = {rkc.x, rkc.y, rkc.z, rkc.w};
      const float de4[4] = {dec.x, dec.y, dec.z, dec.w}, as4[4] = {as.x, as.y, as.z, as.w};
      float r[4], kx[4], v[4], kkr[4];
      float ssq = 0.f;
#pragma unroll
      for (int j = 0; j < 4; ++j) {
        r[j] = pr4[j] + (qr4[j] - pr4[j]) * mr4[j];
        kx[j] = pk4[j] + (qk4[j] - pk4[j]) * mk4[j];
        v[j] = pv4[j] + (qv4[j] - pv4[j]) * mv4[j];
        kkr[j] = kx[j] * kk4[j];
        ssq += kkr[j] * kkr[j];
      }
      ssq = red16(ssq);
      const float rn = rsqrtf(ssq + 1e-6f);
      float fA[4], fWR[4], fB[4], fK[4];
      float br = 0.f, kr = 0.f, rks = 0.f;
#pragma unroll
      for (int j = 0; j < 4; ++j) {
        const float kk = kkr[j] * rn;
        const float kp = kx[j] * (1.f + (as4[j] - 1.f) * ka4[j]);
        fA[j] = -kk; fWR[j] = de4[j] * r[j]; fB[j] = kk * as4[j]; fK[j] = kp;
        br += rbf(fB[j]) * r[j];
        kr += rbf(fK[j]) * r[j];
        rks += r[j] * kp * rk4[j];
      }
      br = red16(br); kr = red16(kr); rks = red16(rks);
      *(float4*)(RWW + (size_t)row * 512 + ch4) = dec;
      bf16_t* d5 = RW5 + (size_t)row * 5 * 512 + ch4;
      *(uint2*)(d5) = make_uint2(pack2(fA[0], fA[1]), pack2(fA[2], fA[3]));
      *(uint2*)(d5 + 512) = make_uint2(pack2(fWR[0], fWR[1]), pack2(fWR[2], fWR[3]));
      *(uint2*)(d5 + 1024) = make_uint2(pack2(fB[0], fB[1]), pack2(fB[2], fB[3]));
      *(uint2*)(d5 + 1536) = make_uint2(pack2(fK[0], fK[1]), pack2(fK[2], fK[3]));
      *(uint2*)(d5 + 2048) = make_uint2(pack2(v[0], v[1]), pack2(v[2], v[3]));
      if ((chunk & 15) == 0) *(float4*)(RWSC + ((size_t)row * 8 + head) * 4) = make_float4(br, kr, rks, 0.f);
    }
  }
  if (row0 >= NTP) {
    for (int idx = tid; idx < 16 * 416; idx += 256) {
      const int tok = idx / 416, c4 = (idx - tok * 416) * 4;
      const int row = row0 + tok;
      const uint2 u = *(const uint2*)(PRE + (size_t)row * PRE_W + c4);
      *(float4*)(p.out + O_S_SHIFT + ((size_t)l * 128 + (row - NTP)) * 1664 + c4) =
          make_float4(bflo(u.x), bfhi(u.x), bflo(u.y), bfhi(u.y));
    }
  } else {
    const int seq = row0 / LP, t0 = row0 - seq * LP;
    if (t0 + 16 == LP) {
      const int row = row0 + 15;
      for (int c4 = tid * 4; c4 < 1664; c4 += 1024) {
        const uint2 u = *(const uint2*)(PRE + (size_t)row * PRE_W + c4);
        *(float4*)(p.out + O_P_SHIFT + ((size_t)l * 8 + seq) * 1664 + c4) = make_float4(bflo(u.x), bfhi(u.x), bflo(u.y), bfhi(u.y));
      }
    }
  }
}

__device__ __forceinline__ void prep_conv_token(const Params& p, int l, int row, int tid, int lane, int wave) {
  const bf16_t* PRE = (const bf16_t*)(p.ws + OFF_PRE);
  bf16_t* SXBC = (bf16_t*)(p.ws + OFF_SXBC);
  float* SDT = (float*)(p.ws + OFF_SDT);
  bf16_t* GQKV = (bf16_t*)(p.ws + OFF_GQKV);
  float* GSC = (float*)(p.ws + OFF_GSC);
  const float* scw = p.in[21] + (size_t)l * 4 * 1024;
  const float* scb = p.in[22] + (size_t)l * 1024;
  const float* gcw = p.in[27] + (size_t)l * 4 * 1536;
  const float* shist = p.in[5] + (size_t)l * 128 * 3 * 1024;
  const float* ghist = p.in[7] + (size_t)l * 128 * 3 * 1536;
  const int b = row - NTP;
  {
    const int c = tid * 4;
    float acc[4] = {scb[c], scb[c + 1], scb[c + 2], scb[c + 3]};
    float cur[4];
    {
      const uint2 u = *(const uint2*)(PRE + (size_t)row * PRE_W + PC_XBC + c);
      cur[0] = bflo(u.x); cur[1] = bfhi(u.x); cur[2] = bflo(u.y); cur[3] = bfhi(u.y);
      const float4 w = *(const float4*)(scw + (size_t)3 * 1024 + c);
      acc[0] += cur[0] * w.x; acc[1] += cur[1] * w.y; acc[2] += cur[2] * w.z; acc[3] += cur[3] * w.w;
    }
    float* o2 = p.out + O_S_SCONV + ((size_t)l * 128 + b) * 3 * 1024;
#pragma unroll
    for (int j = 0; j < 3; ++j) {
      const float4 h = *(const float4*)(shist + ((size_t)b * 3 + j) * 1024 + c);
      const float4 w = *(const float4*)(scw + (size_t)j * 1024 + c);
      acc[0] += h.x * w.x; acc[1] += h.y * w.y; acc[2] += h.z * w.z; acc[3] += h.w * w.w;
      if (j > 0) *(float4*)(o2 + (j - 1) * 1024 + c) = h;
    }
    *(float4*)(o2 + 2 * 1024 + c) = make_float4(cur[0], cur[1], cur[2], cur[3]);
    uint2 o;
    o.x = pack2(siluf_(acc[0]), siluf_(acc[1]));
    o.y = pack2(siluf_(acc[2]), siluf_(acc[3]));
    *(uint2*)(SXBC + (size_t)row * 1024 + c) = o;
    if (tid < 8) {
      const float dtv = softplusf_(bf2f(PRE[(size_t)row * PRE_W + PC_DT + tid]) + p.in[23][l * 8 + tid]);
      const float a = -__expf(p.in[24][l * 8 + tid]);
      SDT[(size_t)row * 16 + tid * 2 + 0] = dtv;
      SDT[(size_t)row * 16 + tid * 2 + 1] = __expf(dtv * a);
    }
  }
  {
    float val[3][2];
    float* o2 = p.out + O_S_GCONV + ((size_t)l * 128 + b) * 3 * 1536;
#pragma unroll
    for (int i = 0; i < 3; ++i) {
      const int c = 2 * tid + 512 * i;
      const unsigned u = *(const unsigned*)(PRE + (size_t)row * PRE_W + PC_QKV + c);
      const float c0 = bflo(u), c1 = bfhi(u);
      const float2 w3 = *(const float2*)(gcw + (size_t)3 * 1536 + c);
      float acc0 = c0 * w3.x, acc1 = c1 * w3.y;
#pragma unroll
      for (int j = 0; j < 3; ++j) {
        const float2 h = *(const float2*)(ghist + ((size_t)b * 3 + j) * 1536 + c);
        const float2 w = *(const float2*)(gcw + (size_t)j * 1536 + c);
        acc0 += h.x * w.x; acc1 += h.y * w.y;
        if (j > 0) *(float2*)(o2 + (j - 1) * 1536 + c) = h;
      }
      *(float2*)(o2 + 2 * 1536 + c) = make_float2(c0, c1);
      val[i][0] = siluf_(acc0); val[i][1] = siluf_(acc1);
    }
    const float ssq = wave_sum(val[0][0] * val[0][0] + val[0][1] * val[0][1]);
    const float ssk = wave_sum(val[1][0] * val[1][0] + val[1][1] * val[1][1]);
    const float rq = rsqrtf(ssq + 1e-6f) * 0.08838834764831845f;
    const float rk = rsqrtf(ssk + 1e-6f);
    const unsigned uq = pack2(val[0][0] * rq, val[0][1] * rq);
    const unsigned uk = pack2(val[1][0] * rk, val[1][1] * rk);
    const unsigned uv = pack2(val[2][0], val[2][1]);
    const float qk = wave_sum(bflo(uq) * bflo(uk) + bfhi(uq) * bfhi(uk));
    *(unsigned*)(GQKV + (size_t)row * 1536 + 2 * tid) = uq;
    *(unsigned*)(GQKV + (size_t)row * 1536 + 512 + 2 * tid) = uk;
    *(unsigned*)(GQKV + (size_t)row * 1536 + 1024 + 2 * tid) = uv;
    if (lane == 0) {
      const int h = wave;
      const float g = -__expf(p.in[29][l * 4 + h]) *
                      softplusf_(bf2f(PRE[(size_t)row * PRE_W + PC_GA + h]) + p.in[28][l * 4 + h]);
      *(float4*)(GSC + ((size_t)row * 4 + h) * 4) =
          make_float4(__expf(g), sigmoidf_(bf2f(PRE[(size_t)row * PRE_W + PC_GB + h])), qk, 0.f);
    }
  }
}

__device__ __forceinline__ void prep_conv(const Params& p, int l, int item) {
  const int tid = otid(), lane = tid & 63, wave = tid >> 6;
  const int row0 = item * 8;
  if (row0 >= NTP) {
    for (int k = 0; k < 8; ++k) prep_conv_token(p, l, row0 + k, tid, lane, wave);
    return;
  }
  const bf16_t* PRE = (const bf16_t*)(p.ws + OFF_PRE);
  bf16_t* SXBC = (bf16_t*)(p.ws + OFF_SXBC);
  float* SDT = (float*)(p.ws + OFF_SDT);
  bf16_t* GQKV = (bf16_t*)(p.ws + OFF_GQKV);
  float* GSC = (float*)(p.ws + OFF_GSC);
  const int seq = row0 / LP, t0 = row0 - seq * LP;
  {
    const int c = tid * 4;
    const float* scw = p.in[21] + (size_t)l * 4 * 1024;
    const float4 w0 = *(const float4*)(scw + c), w1 = *(const float4*)(scw + 1024 + c);
    const float4 w2 = *(const float4*)(scw + 2048 + c), w3 = *(const float4*)(scw + 3072 + c);
    const float4 bs = *(const float4*)(p.in[22] + (size_t)l * 1024 + c);
    uint2 x[11];
#pragma unroll
    for (int j = 0; j < 11; ++j) {
      x[j] = make_uint2(0u, 0u);
      if (t0 - 3 + j >= 0) x[j] = *(const uint2*)(PRE + (size_t)(row0 - 3 + j) * PRE_W + PC_XBC + c);
    }
#pragma unroll
    for (int k = 0; k < 8; ++k) {
      const float a0 = bs.x + bflo(x[k].x) * w0.x + bflo(x[k + 1].x) * w1.x + bflo(x[k + 2].x) * w2.x + bflo(x[k + 3].x) * w3.x;
      const float a1 = bs.y + bfhi(x[k].x) * w0.y + bfhi(x[k + 1].x) * w1.y + bfhi(x[k + 2].x) * w2.y + bfhi(x[k + 3].x) * w3.y;
      const float a2 = bs.z + bflo(x[k].y) * w0.z + bflo(x[k + 1].y) * w1.z + bflo(x[k + 2].y) * w2.z + bflo(x[k + 3].y) * w3.z;
      const float a3 = bs.w + bfhi(x[k].y) * w0.w + bfhi(x[k + 1].y) * w1.w + bfhi(x[k + 2].y) * w2.w + bfhi(x[k + 3].y) * w3.w;
      uint2 o;
      o.x = pack2(siluf_(a0), siluf_(a1));
      o.y = pack2(siluf_(a2), siluf_(a3));
      *(uint2*)(SXBC + (size_t)(row0 + k) * 1024 + c) = o;
    }
    if (t0 + 8 == LP) {
#pragma unroll
      for (int j = 0; j < 3; ++j) {
        const uint2 u = x[8 + j];
        *(float4*)(p.out + O_P_SCONV + (((size_t)l * 8 + seq) * 3 + j) * 1024 + c) =
            make_float4(bflo(u.x), bfhi(u.x), bflo(u.y), bfhi(u.y));
      }
    }
    if (tid < 64) {
      const int tok = tid >> 3, h = tid & 7;
      const int row = row0 + tok;
      const float dtv = softplusf_(bf2f(PRE[(size_t)row * PRE_W + PC_DT + h]) + p.in[23][l * 8 + h]);
      const float a = -__expf(p.in[24][l * 8 + h]);
      SDT[(size_t)row * 16 + h * 2 + 0] = dtv;
      SDT[(size_t)row * 16 + h * 2 + 1] = __expf(dtv * a);
    }
  }
  {
    const float* gcw = p.in[27] + (size_t)l * 4 * 1536;
    unsigned x[3][11];
    float2 w[3][4];
#pragma unroll
    for (int i = 0; i < 3; ++i) {
      const int c = 2 * tid + 512 * i;
#pragma unroll
      for (int j = 0; j < 4; ++j) w[i][j] = *(const float2*)(gcw + (size_t)j * 1536 + c);
#pragma unroll
      for (int j = 0; j < 11; ++j) {
        x[i][j] = 0u;
        if (t0 - 3 + j >= 0) x[i][j] = *(const unsigned*)(PRE + (size_t)(row0 - 3 + j) * PRE_W + PC_QKV + c);
      }
    }
    if (t0 + 8 == LP) {
#pragma unroll
      for (int i = 0; i < 3; ++i)
#pragma unroll
        for (int j = 0; j < 3; ++j)
          *(float2*)(p.out + O_P_GCONV + (((size_t)l * 8 + seq) * 3 + j) * 1536 + 2 * tid + 512 * i) =
              make_float2(bflo(x[i][8 + j]), bfhi(x[i][8 + j]));
    }
    const float nega = -__expf(p.in[29][l * 4 + wave]);
    const float dtb = p.in[28][l * 4 + wave];
#pragma unroll
    for (int k = 0; k < 8; ++k) {
      float val[3][2];
#pragma unroll
      for (int i = 0; i < 3; ++i) {
        const float a0 = bflo(x[i][k]) * w[i][0].x + bflo(x[i][k + 1]) * w[i][1].x + bflo(x[i][k + 2]) * w[i][2].x + bflo(x[i][k + 3]) * w[i][3].x;
        const float a1 = bfhi(x[i][k]) * w[i][0].y + bfhi(x[i][k + 1]) * w[i][1].y + bfhi(x[i][k + 2]) * w[i][2].y + bfhi(x[i][k + 3]) * w[i][3].y;
        val[i][0] = siluf_(a0); val[i][1] = siluf_(a1);
      }
      const int row = row0 + k;
      const float ssq = wave_sum(val[0][0] * val[0][0] + val[0][1] * val[0][1]);
      const float ssk = wave_sum(val[1][0] * val[1][0] + val[1][1] * val[1][1]);
      const float rq = rsqrtf(ssq + 1e-6f) * 0.08838834764831845f;
      const float rk = rsqrtf(ssk + 1e-6f);
      const unsigned uq = pack2(val[0][0] * rq, val[0][1] * rq);
      const unsigned uk = pack2(val[1][0] * rk, val[1][1] * rk);
      const unsigned uv = pack2(val[2][0], val[2][1]);
      const float qk = wave_sum(bflo(uq) * bflo(uk) + bfhi(uq) * bfhi(uk));
      *(unsigned*)(GQKV + (size_t)row * 1536 + 2 * tid) = uq;
      *(unsigned*)(GQKV + (size_t)row * 1536 + 512 + 2 * tid) = uk;
      *(unsigned*)(GQKV + (size_t)row * 1536 + 1024 + 2 * tid) = uv;
      if (lane == 0) {
        const int h = wave;
        const float g = nega * softplusf_(bf2f(PRE[(size_t)row * PRE_W + PC_GA + h]) + dtb);
        *(float4*)(GSC + ((size_t)row * 4 + h) * 4) =
            make_float4(__expf(g), sigmoidf_(bf2f(PRE[(size_t)row * PRE_W + PC_GB + h])), qk, 0.f);
      }
    }
  }
}

__device__ __forceinline__ void phase_prep(const Params& p, int l, char* smem) {
  const int ng = NT / 16;
  const int nc = NT / 8;
  for (int it = blockIdx.x; it < ng + nc; it += gridDim.x) {
    if (it < ng) prep_rwkv(p, l, it, smem); else prep_conv(p, l, it - ng);
  }
}

using f32x2 = __attribute__((ext_vector_type(2))) float;
__device__ __forceinline__ f32x2 lo2(const f32x4& v) { return __builtin_shufflevector(v, v, 0, 1); }
__device__ __forceinline__ f32x2 hi2(const f32x4& v) { return __builtin_shufflevector(v, v, 2, 3); }
__device__ __forceinline__ f32x2 splat2(float x) { return (f32x2){x, x}; }

__device__ __forceinline__ void cvt8(const u32x4& u, float4& lo, float4& hi) {
  lo = make_float4(bflo(u.x), bfhi(u.x), bflo(u.y), bfhi(u.y));
  hi = make_float4(bflo(u.z), bfhi(u.z), bflo(u.w), bfhi(u.w));
}

#define SCAN_INTERLEAVE(nds, nvalu)                                   \
  _Pragma("unroll") for (int i_ = 0; i_ < (nds); ++i_) {               \
    __builtin_amdgcn_sched_group_barrier(0x100, 1, 0);                 \
    __builtin_amdgcn_sched_group_barrier(0x002, (nvalu), 0);           \
  }
struct RwP { f32x4 pw; u32x4 pb[3]; float4 psc; uint2 zn; };
struct SsP { u32x4 pb[3]; float2 psc; uint2 zn; };
struct GdP { u32x4 pb[3]; float4 psc; unsigned zn; };
struct RwRegs { f32x4 a[2], wr[2], w[2], b[2], k[2]; f32x4 sc; f32x2 v; };
__device__ __forceinline__ void rw_load(RwRegs& R, const float* vb, const float* sb, int t, int k0, int vrow0) {
  const float* vt = vb + t * 384 + k0;
#pragma unroll
  for (int q = 0; q < 2; ++q) {
    R.a[q] = *(const f32x4*)(vt + q * 4);
    R.wr[q] = *(const f32x4*)(vt + 128 + q * 4);
    R.w[q] = *(const f32x4*)(vt + 64 + q * 4);
    R.b[q] = *(const f32x4*)(vt + 192 + q * 4);
    R.k[q] = *(const f32x4*)(vt + 256 + q * 4);
  }
  R.v = *(const f32x2*)(vb + t * 384 + 320 + vrow0);
  R.sc = *(const f32x4*)(sb + t * 4);
}
__device__ __forceinline__ f32x2 rw_step(f32x2 (&S)[2][4], const RwRegs& R) {
  float sa[2], sy[2];
#pragma unroll
  for (int r = 0; r < 2; ++r) {
    f32x2 a0 = S[r][0] * lo2(R.a[0]);
    f32x2 a1 = S[r][1] * hi2(R.a[0]);
    f32x2 y0 = S[r][0] * lo2(R.wr[0]);
    f32x2 y1 = S[r][1] * hi2(R.wr[0]);
    a0 += S[r][2] * lo2(R.a[1]);
    a1 += S[r][3] * hi2(R.a[1]);
    y0 += S[r][2] * lo2(R.wr[1]);
    y1 += S[r][3] * hi2(R.wr[1]);
    a0 += a1; y0 += y1;
    sa[r] = a0.x + a0.y; sy[r] = y0.x + y0.y;
  }
  sa[0] = red8(sa[0]); sa[1] = red8(sa[1]); sy[0] = red8(sy[0]); sy[1] = red8(sy[1]);
  f32x2 yv;
#pragma unroll
  for (int r = 0; r < 2; ++r) {
    const float vr = r ? R.v.y : R.v.x;
    const f32x2 sa2 = splat2(sa[r]), vv2 = splat2(vr);
    S[r][0] = S[r][0] * lo2(R.w[0]) + (sa2 * lo2(R.b[0]) + vv2 * lo2(R.k[0]));
    S[r][1] = S[r][1] * hi2(R.w[0]) + (sa2 * hi2(R.b[0]) + vv2 * hi2(R.k[0]));
    S[r][2] = S[r][2] * lo2(R.w[1]) + (sa2 * lo2(R.b[1]) + vv2 * lo2(R.k[1]));
    S[r][3] = S[r][3] * hi2(R.w[1]) + (sa2 * hi2(R.b[1]) + vv2 * hi2(R.k[1]));
    const float y = sy[r] + sa[r] * R.sc.x + vr * R.sc.y;
    if (r) yv.y = y; else yv.x = y;
  }
  return yv;
}

__device__ __forceinline__ void scan_rwkv(const Params& p, int l, int seq, int h, char* smem) {
  float* vec = (float*)smem;
  float* scb = vec + 2 * 16 * 384;
  float* yb = scb + 2 * 16 * 4;
  const int tid = otid(), lane = tid & 63, wave = tid >> 6;
  const int vrow0 = wave * 16 + (lane >> 3) * 2, part = lane & 7, k0 = part * 8;
  int T, row0; const float* st_in; float* st_out;
  if (seq < 8) { T = LP; row0 = seq * LP; st_in = nullptr; st_out = p.out + O_P_WKV + (((size_t)l * 8 + seq) * 8 + h) * 4096; }
  else { const int b = seq - 8; T = 1; row0 = NTP + b;
         st_in = p.in[2] + (((size_t)l * 128 + b) * 8 + h) * 4096;
         st_out = p.out + O_S_WKV + (((size_t)l * 128 + b) * 8 + h) * 4096; }
  f32x2 S[2][4];
  if (st_in) {
#pragma unroll
    for (int r = 0; r < 2; ++r)
#pragma unroll
      for (int q = 0; q < 2; ++q) {
        const f32x4 v = *(const f32x4*)(st_in + (vrow0 + r) * 64 + k0 + q * 4);
        S[r][2 * q] = lo2(v); S[r][2 * q + 1] = hi2(v);
      }
  } else {
#pragma unroll
    for (int r = 0; r < 2; ++r)
#pragma unroll
      for (int i = 0; i < 4; ++i) S[r][i] = splat2(0.f);
  }
  const float* RWW = (const float*)(p.ws + OFF_RWW);
  const bf16_t* RW5 = (const bf16_t*)(p.ws + OFF_RW5);
  const float* RWSC = (const float*)(p.ws + OFF_RWSC);
  const bf16_t* POST = (const bf16_t*)(p.ws + OFF_POST);
  bf16_t* BR = (bf16_t*)(p.out + O_YP);
  const int st_t = tid >> 4, st_j = tid & 15;
  const float4 gw = *(const float4*)(p.in[19] + (size_t)l * 512 + h * 64 + st_j * 4);
  const float4 gb = *(const float4*)(p.in[20] + (size_t)l * 512 + h * 64 + st_j * 4);
  const int nch = (T + 15) >> 4;
  uint2 zc = make_uint2(0, 0);

  const int tcl = (T >= 16) ? 1 : 0;
  const int oW = (row0 + st_t * tcl) * 512 + h * 64 + st_j * 4;
  const int oZ = (row0 + st_t * tcl) * POST_W + QC_RWZ + h * 64 + st_j * 4;
  const int oS = ((row0 + (tid & 15) * tcl) * 8 + h) * 4;
  int oB[3];
#pragma unroll
  for (int i = 0; i < 3; ++i) {
    const int idx = (tid + 256 * i < 640) ? tid + 256 * i : 0;
    const int arr = idx >> 7, rem = idx & 127, tt = rem >> 3, chn = rem & 7;
    oB[i] = ((row0 + tt * tcl) * 5 + arr) * 512 + h * 64 + chn * 8;
  }
  auto prefetch = [&](RwP& P, int c)
  {
    const int cc = c * 16;
    P.pw = *(const f32x4*)(RWW + oW + cc * 512);
    P.zn = *(const uint2*)(POST + oZ + cc * POST_W);
    P.pb[0] = *(const u32x4*)(RW5 + oB[0] + cc * 2560);
    P.pb[1] = *(const u32x4*)(RW5 + oB[1] + cc * 2560);
    if (tid < 128) P.pb[2] = *(const u32x4*)(RW5 + oB[2] + cc * 2560);
    if (tid < 16) P.psc = *(const float4*)(RWSC + oS + cc * 32);
  };
  int sB_[3];
#pragma unroll
  for (int i = 0; i < 3; ++i) {
    const int idx = (tid + 256 * i < 640) ? tid + 256 * i : 0;
    const int arr = idx >> 7, rem = idx & 127, tt = rem >> 3, chn = rem & 7;
    sB_[i] = tt * 384 + ((arr == 0) ? 0 : arr + 1) * 64 + chn * 8;
  }
  const int sW_ = st_t * 384 + 64 + st_j * 4;
  auto stage = [&](const RwP& P, int buf)
  {
    float* vb_ = vec + buf * 16 * 384;
    *(f32x4*)(vb_ + sW_) = P.pw;
    float4 lo, hi;
    cvt8(P.pb[0], lo, hi); *(float4*)(vb_ + sB_[0]) = lo; *(float4*)(vb_ + sB_[0] + 4) = hi;
    cvt8(P.pb[1], lo, hi); *(float4*)(vb_ + sB_[1]) = lo; *(float4*)(vb_ + sB_[1] + 4) = hi;
    if (tid < 128) { cvt8(P.pb[2], lo, hi); *(float4*)(vb_ + sB_[2]) = lo; *(float4*)(vb_ + sB_[2] + 4) = hi; }
    if (tid < 16) *(float4*)(scb + buf * 64 + tid * 4) = P.psc;
  };
  RwP P0{}, P1{};
  __syncthreads();
  prefetch(P0, 0);
  stage(P0, 0);
  zc = P0.zn;
  if (nch > 1) prefetch(P1, 1);
  __syncthreads();
  auto body = [&](int c, RwP& Pfree, const RwP& Pfull) {
    const int cur = c & 1;
    prefetch(Pfree, min(c + 2, nch - 1));
    const int nsteps = min(16, T - c * 16);
    const float* vb = vec + cur * 16 * 384;
    const float* sb = scb + cur * 64;
    RwRegs RA, RB;
    float* ydummy = yb + 16 * 64 + tid * 2;
    rw_load(RA, vb, sb, 0, k0, vrow0);
    for (int t = 0; t < nsteps; t += 2) {
      rw_load(RB, vb, sb, min(t + 1, 15), k0, vrow0);
      const f32x2 y0v = rw_step(S, RA);
      *(f32x2*)((part == 0) ? (yb + t * 64 + vrow0) : ydummy) = y0v;
      SCAN_INTERLEAVE(13, 4);
      if (t + 1 < nsteps) {
        rw_load(RA, vb, sb, min(t + 2, 15), k0, vrow0);
        const f32x2 y1v = rw_step(S, RB);
        *(f32x2*)((part == 0) ? (yb + (t + 1) * 64 + vrow0) : ydummy) = y1v;
        SCAN_INTERLEAVE(13, 4);
      }
    }
    __syncthreads();
    {
      const int t = st_t, c4 = st_j * 4;
      const bool valid = t < nsteps;
      const float4 y = *(const float4*)(yb + t * 64 + c4);
      float s = red16(y.x + y.y + y.z + y.w);
      const float mean = s * (1.f / 64.f);
      const float d0 = y.x - mean, d1 = y.y - mean, d2 = y.z - mean, d3 = y.w - mean;
      const float var = red16(d0 * d0 + d1 * d1 + d2 * d2 + d3 * d3) * (1.f / 64.f);
      const float rstd = rsqrtf(var + 64e-5f);
      if (valid) {
        const int row = row0 + c * 16 + t;
        const float rks = sb[t * 4 + 2];
        const float4 v4 = *(const float4*)(vb + t * 384 + 320 + c4);
        const float o0 = (d0 * rstd * gw.x + gb.x + rks * v4.x) * siluf_(bflo(zc.x));
        const float o1 = (d1 * rstd * gw.y + gb.y + rks * v4.y) * siluf_(bfhi(zc.x));
        const float o2 = (d2 * rstd * gw.z + gb.z + rks * v4.z) * siluf_(bflo(zc.y));
        const float o3 = (d3 * rstd * gw.w + gb.w + rks * v4.w) * siluf_(bfhi(zc.y));
        uint2 o; o.x = pack2(o0, o1); o.y = pack2(o2, o3);
        *(uint2*)(BR + (size_t)row * 1536 + h * 64 + c4) = o;
      }
    }
    if (c + 1 < nch) { stage(Pfull, cur ^ 1); zc = Pfull.zn; }
    __syncthreads();
  };
  for (int c = 0; c < nch; c += 2) {
    body(c, P0, P1);
    if (c + 1 < nch) body(c + 1, P1, P0);
  }
#pragma unroll
  for (int r = 0; r < 2; ++r)
#pragma unroll
    for (int q = 0; q < 2; ++q)
      *(f32x4*)(st_out + (vrow0 + r) * 64 + k0 + q * 4) =
          (f32x4){S[r][2 * q].x, S[r][2 * q].y, S[r][2 * q + 1].x, S[r][2 * q + 1].y};
}

struct SsRegs { f32x4 B[4], C[4]; f32x2 sc; f32x2 x; };
__device__ __forceinline__ void ss_load(SsRegs& R, const float* vb, const float* sb, int t, int n0, int prow0) {
  const float* vt = vb + t * 320;
#pragma unroll
  for (int q = 0; q < 4; ++q) {
    R.B[q] = *(const f32x4*)(vt + n0 + q * 4);
    R.C[q] = *(const f32x4*)(vt + 128 + n0 + q * 4);
  }
  R.x = *(const f32x2*)(vt + 256 + prow0);
  R.sc = *(const f32x2*)(sb + t * 2);
}
__device__ __forceinline__ f32x2 ss_step(f32x2 (&S)[2][8], const SsRegs& R) {
  const f32x2 dA2 = splat2(R.sc.y);
  f32x2 out;
#pragma unroll
  for (int r = 0; r < 2; ++r) {
    const f32x2 xdt2 = splat2((r ? R.x.y : R.x.x) * R.sc.x);
    f32x2 y0 = splat2(0.f), y1 = splat2(0.f);
#pragma unroll
    for (int q = 0; q < 4; ++q) {
      S[r][2 * q] = S[r][2 * q] * dA2 + xdt2 * lo2(R.B[q]);
      S[r][2 * q + 1] = S[r][2 * q + 1] * dA2 + xdt2 * hi2(R.B[q]);
      y0 += S[r][2 * q] * lo2(R.C[q]);
      y1 += S[r][2 * q + 1] * hi2(R.C[q]);
    }
    y0 += y1;
    const float y = red8(y0.x + y0.y);
    if (r) out.y = y; else out.x = y;
  }
  return out;
}

__device__ __forceinline__ void scan_ssm(const Params& p, int l, int seq, int h, char* smem) {
  float* vec = (float*)smem;
  float* scb = vec + 2 * 16 * 320;
  float* yb = scb + 2 * 16 * 2;
  const int tid = otid(), lane = tid & 63, wave = tid >> 6;
  const int prow0 = wave * 16 + (lane >> 3) * 2, part = lane & 7, n0 = part * 16;
  const int g = h >> 2;
  int T, row0; const float* st_in; float* st_out;
  if (seq < 8) { T = LP; row0 = seq * LP; st_in = nullptr; st_out = p.out + O_P_SSM + (((size_t)l * 8 + seq) * 8 + h) * 8192; }
  else { const int b = seq - 8; T = 1; row0 = NTP + b;
         st_in = p.in[4] + (((size_t)l * 128 + b) * 8 + h) * 8192;
         st_out = p.out + O_S_SSM + (((size_t)l * 128 + b) * 8 + h) * 8192; }
  f32x2 S[2][8];
  if (st_in) {
#pragma unroll
    for (int r = 0; r < 2; ++r)
#pragma unroll
      for (int q = 0; q < 4; ++q) {
        const f32x4 v = *(const f32x4*)(st_in + (prow0 + r) * 128 + n0 + q * 4);
        S[r][2 * q] = lo2(v); S[r][2 * q + 1] = hi2(v);
      }
  } else {
#pragma unroll
    for (int r = 0; r < 2; ++r)
#pragma unroll
      for (int i = 0; i < 8; ++i) S[r][i] = splat2(0.f);
  }
  const bf16_t* SXBC = (const bf16_t*)(p.ws + OFF_SXBC);
  const float* SDT = (const float*)(p.ws + OFF_SDT);
  const bf16_t* POST = (const bf16_t*)(p.ws + OFF_POST);
  bf16_t* BR = (bf16_t*)(p.out + O_YP);
  float* STAT = (float*)(p.ws + OFF_STAT);
  const float dskip = p.in[25][l * 8 + h];
  const int nch = (T + 15) >> 4;
  uint2 zc = make_uint2(0, 0);
  const int st_t = tid >> 4, st_j = tid & 15;

  const int tcl = (T >= 16) ? 1 : 0;
  const int oZ = (row0 + st_t * tcl) * POST_W + QC_SSMZ + h * 64 + st_j * 4;
  const int oS = (row0 + (tid & 15) * tcl) * 16 + h * 2;
  int oB[3];
#pragma unroll
  for (int i = 0; i < 3; ++i) {
    const int idx = (tid + 256 * i < 640) ? tid + 256 * i : 0;
    const int tt = idx / 40, chn = idx - tt * 40;
    int col;
    if (chn < 16) col = 512 + g * 128 + chn * 8;
    else if (chn < 32) col = 768 + g * 128 + (chn - 16) * 8;
    else col = h * 64 + (chn - 32) * 8;
    oB[i] = (row0 + tt * tcl) * 1024 + col;
  }
  auto prefetch = [&](SsP& P, int c)
  {
    const int cc = c * 16;
    P.pb[0] = *(const u32x4*)(SXBC + oB[0] + cc * 1024);
    P.pb[1] = *(const u32x4*)(SXBC + oB[1] + cc * 1024);
    if (tid < 128) P.pb[2] = *(const u32x4*)(SXBC + oB[2] + cc * 1024);
    P.zn = *(const uint2*)(POST + oZ + cc * POST_W);
    if (tid < 16) P.psc = *(const float2*)(SDT + oS + cc * 16);
  };
  int sB_[3];
#pragma unroll
  for (int i = 0; i < 3; ++i) {
    const int idx = (tid + 256 * i < 640) ? tid + 256 * i : 0;
    const int tt = idx / 40, chn = idx - tt * 40;
    sB_[i] = tt * 320 + chn * 8;
  }
  auto stage = [&](const SsP& P, int buf)
  {
    float* vb_ = vec + buf * 16 * 320;
    float4 lo, hi;
    cvt8(P.pb[0], lo, hi); *(float4*)(vb_ + sB_[0]) = lo; *(float4*)(vb_ + sB_[0] + 4) = hi;
    cvt8(P.pb[1], lo, hi); *(float4*)(vb_ + sB_[1]) = lo; *(float4*)(vb_ + sB_[1] + 4) = hi;
    if (tid < 128) { cvt8(P.pb[2], lo, hi); *(float4*)(vb_ + sB_[2]) = lo; *(float4*)(vb_ + sB_[2] + 4) = hi; }
    if (tid < 16) *(float2*)(scb + buf * 32 + tid * 2) = P.psc;
  };
  SsP P0{}, P1{};
  __syncthreads();
  prefetch(P0, 0);
  stage(P0, 0);
  zc = P0.zn;
  if (nch > 1) prefetch(P1, 1);
  __syncthreads();
  auto body = [&](int c, SsP& Pfree, const SsP& Pfull) {
    const int cur = c & 1;
    prefetch(Pfree, min(c + 2, nch - 1));
    const int nsteps = min(16, T - c * 16);
    const float* vb = vec + cur * 16 * 320;
    const float* sb = scb + cur * 32;
    SsRegs RA, RB;
    float* ydummy = yb + 16 * 64 + tid * 2;
    ss_load(RA, vb, sb, 0, n0, prow0);
    for (int t = 0; t < nsteps; t += 2) {
      ss_load(RB, vb, sb, min(t + 1, 15), n0, prow0);
      const f32x2 y0v = ss_step(S, RA);
      *(f32x2*)((part == 0) ? (yb + t * 64 + prow0) : ydummy) = y0v;
      SCAN_INTERLEAVE(10, 5);
      if (t + 1 < nsteps) {
        ss_load(RA, vb, sb, min(t + 2, 15), n0, prow0);
        const f32x2 y1v = ss_step(S, RB);
        *(f32x2*)((part == 0) ? (yb + (t + 1) * 64 + prow0) : ydummy) = y1v;
        SCAN_INTERLEAVE(10, 5);
      }
    }
    __syncthreads();
    {
      const int t = st_t, c4 = st_j * 4;
      const bool valid = t < nsteps;
      const int row = row0 + c * 16 + (valid ? t : 0);
      const float4 y = *(const float4*)(yb + t * 64 + c4);
      const float4 x = *(const float4*)(vb + t * 320 + 256 + c4);
      const float g0 = (y.x + dskip * x.x) * siluf_(bflo(zc.x));
      const float g1 = (y.y + dskip * x.y) * siluf_(bfhi(zc.x));
      const float g2 = (y.z + dskip * x.z) * siluf_(bflo(zc.y));
      const float g3 = (y.w + dskip * x.w) * siluf_(bfhi(zc.y));
      const float ssq = red16(g0 * g0 + g1 * g1 + g2 * g2 + g3 * g3);
      if (valid) {
        uint2 o; o.x = pack2(g0, g1); o.y = pack2(g2, g3);
        *(uint2*)(BR + (size_t)row * 1536 + 512 + h * 64 + c4) = o;
        if (st_j == 0) STAT[(size_t)row * 32 + h] = ssq;
      }
    }
    if (c + 1 < nch) { stage(Pfull, cur ^ 1); zc = Pfull.zn; }
    __syncthreads();
  };
  for (int c = 0; c < nch; c += 2) {
    body(c, P0, P1);
    if (c + 1 < nch) body(c + 1, P1, P0);
  }
#pragma unroll
  for (int r = 0; r < 2; ++r)
#pragma unroll
    for (int q = 0; q < 4; ++q)
      *(f32x4*)(st_out + (prow0 + r) * 128 + n0 + q * 4) =
          (f32x4){S[r][2 * q].x, S[r][2 * q].y, S[r][2 * q + 1].x, S[r][2 * q + 1].y};
}

struct GdRegs { f32x4 q[4], k[4]; f32x4 sc; float v; };
__device__ __forceinline__ void gd_load(GdRegs& R, const float* vb, const float* sb, int t, int k0, int cl) {
  const float* vt = vb + t * 288;
#pragma unroll
  for (int q = 0; q < 4; ++q) {
    R.q[q] = *(const f32x4*)(vt + k0 + q * 4);
    R.k[q] = *(const f32x4*)(vt + 128 + k0 + q * 4);
  }
  R.v = vt[256 + cl];
  R.sc = *(const f32x4*)(sb + t * 4);
}
__device__ __forceinline__ float gd_step(f32x2 (&S)[8], const GdRegs& R) {
  f32x2 k0a = splat2(0.f), k1a = splat2(0.f), q0a = splat2(0.f), q1a = splat2(0.f);
#pragma unroll
  for (int q = 0; q < 4; ++q) {
    k0a += S[2 * q] * lo2(R.k[q]);
    k1a += S[2 * q + 1] * hi2(R.k[q]);
    q0a += S[2 * q] * lo2(R.q[q]);
    q1a += S[2 * q + 1] * hi2(R.q[q]);
  }
  k0a += k1a; q0a += q1a;
  const float dK = red8(k0a.x + k0a.y), dQ = red8(q0a.x + q0a.y);
  const float vn = R.sc.y * (R.v - R.sc.x * dK);
  const float o = R.sc.x * dQ + R.sc.z * vn;
  const f32x2 al2 = splat2(R.sc.x), vn2 = splat2(vn);
#pragma unroll
  for (int q = 0; q < 4; ++q) {
    S[2 * q] = S[2 * q] * al2 + lo2(R.k[q]) * vn2;
    S[2 * q + 1] = S[2 * q + 1] * al2 + hi2(R.k[q]) * vn2;
  }
  return o;
}

__device__ __forceinline__ void scan_gdn(const Params& p, int l, int seq, int h, int qt, char* smem) {
  float* vec = (float*)smem;
  float* scb = vec + 2 * 16 * 288;
  float* yb = scb + 2 * 16 * 4;
  const int tid = otid(), lane = tid & 63, wave = tid >> 6;
  const int cl = wave * 8 + (lane >> 3), part = lane & 7, k0 = part * 16;
  const int col = qt * 32 + cl;
  int T, row0; const float* st_in; float* st_out;
  if (seq < 8) { T = LP; row0 = seq * LP; st_in = nullptr; st_out = p.out + O_P_GDN + (((size_t)l * 8 + seq) * 4 + h) * 16384; }
  else { const int b = seq - 8; T = 1; row0 = NTP + b;
         st_in = p.in[6] + (((size_t)l * 128 + b) * 4 + h) * 16384;
         st_out = p.out + O_S_GDN + (((size_t)l * 128 + b) * 4 + h) * 16384; }
  f32x2 S[8];
  if (st_in) {
#pragma unroll
    for (int i = 0; i < 8; ++i) {
      S[i].x = st_in[(size_t)(k0 + 2 * i) * 128 + col];
      S[i].y = st_in[(size_t)(k0 + 2 * i + 1) * 128 + col];
    }
  } else {
#pragma unroll
    for (int i = 0; i < 8; ++i) S[i] = splat2(0.f);
  }
  const bf16_t* GQKV = (const bf16_t*)(p.ws + OFF_GQKV);
  const float* GSC = (const float*)(p.ws + OFF_GSC);
  const bf16_t* POST = (const bf16_t*)(p.ws + OFF_POST);
  bf16_t* BR = (bf16_t*)(p.out + O_YP);
  float* STAT = (float*)(p.ws + OFF_STAT);
  const int nch = (T + 15) >> 4;
  unsigned zc = 0;
  const int st_t = tid >> 4, st_j = tid & 15;

  const int tcl = (T >= 16) ? 1 : 0;
  const int oZ = (row0 + st_t * tcl) * POST_W + QC_GDNZ + h * 128 + qt * 32 + st_j * 2;
  const int oS = ((row0 + (tid & 15) * tcl) * 4 + h) * 4;
  int oB[3];
#pragma unroll
  for (int i = 0; i < 3; ++i) {
    const int idx = (tid + 256 * i < 576) ? tid + 256 * i : 0;
    const int tt = idx / 36, chn = idx - tt * 36;
    int cc_;
    if (chn < 16) cc_ = h * 128 + chn * 8;
    else if (chn < 32) cc_ = 512 + h * 128 + (chn - 16) * 8;
    else cc_ = 1024 + h * 128 + qt * 32 + (chn - 32) * 8;
    oB[i] = (row0 + tt * tcl) * 1536 + cc_;
  }
  auto prefetch = [&](GdP& P, int c)
  {
    const int cc = c * 16;
    P.pb[0] = *(const u32x4*)(GQKV + oB[0] + cc * 1536);
    P.pb[1] = *(const u32x4*)(GQKV + oB[1] + cc * 1536);
    if (tid < 64) P.pb[2] = *(const u32x4*)(GQKV + oB[2] + cc * 1536);
    P.zn = *(const unsigned*)(POST + oZ + cc * POST_W);
    if (tid < 16) P.psc = *(const float4*)(GSC + oS + cc * 16);
  };
  int sB_[3];
#pragma unroll
  for (int i = 0; i < 3; ++i) {
    const int idx = (tid + 256 * i < 576) ? tid + 256 * i : 0;
    const int tt = idx / 36, chn = idx - tt * 36;
    sB_[i] = tt * 288 + chn * 8;
  }
  auto stage = [&](const GdP& P, int buf)
  {
    float* vb_ = vec + buf * 16 * 288;
    float4 lo, hi;
    cvt8(P.pb[0], lo, hi); *(float4*)(vb_ + sB_[0]) = lo; *(float4*)(vb_ + sB_[0] + 4) = hi;
    cvt8(P.pb[1], lo, hi); *(float4*)(vb_ + sB_[1]) = lo; *(float4*)(vb_ + sB_[1] + 4) = hi;
    if (tid < 64) { cvt8(P.pb[2], lo, hi); *(float4*)(vb_ + sB_[2]) = lo; *(float4*)(vb_ + sB_[2] + 4) = hi; }
    if (tid < 16) *(float4*)(scb + buf * 64 + tid * 4) = P.psc;
  };
  GdP P0{}, P1{};
  __syncthreads();
  prefetch(P0, 0);
  stage(P0, 0);
  zc = P0.zn;
  if (nch > 1) prefetch(P1, 1);
  __syncthreads();
  auto body = [&](int c, GdP& Pfree, const GdP& Pfull) {
    const int cur = c & 1;
    prefetch(Pfree, min(c + 2, nch - 1));
    const int nsteps = min(16, T - c * 16);
    const float* vb = vec + cur * 16 * 288;
    const float* sb = scb + cur * 64;
    GdRegs RA, RB;
    float* ydummy = yb + 16 * 32 + tid;
    gd_load(RA, vb, sb, 0, k0, cl);
    for (int t = 0; t < nsteps; t += 2) {
      gd_load(RB, vb, sb, min(t + 1, 15), k0, cl);
      const float o0v = gd_step(S, RA);
      *((part == 0) ? (yb + t * 32 + cl) : ydummy) = o0v;
      SCAN_INTERLEAVE(10, 4);
      if (t + 1 < nsteps) {
        gd_load(RA, vb, sb, min(t + 2, 15), k0, cl);
        const float o1v = gd_step(S, RB);
        *((part == 0) ? (yb + (t + 1) * 32 + cl) : ydummy) = o1v;
        SCAN_INTERLEAVE(10, 4);
      }
    }
    __syncthreads();
    {
      const int t = st_t, c2 = st_j * 2;
      const bool valid = t < nsteps;
      const int row = row0 + c * 16 + (valid ? t : 0);
      const float2 o = *(const float2*)(yb + t * 32 + c2);
      const float ssq = red16(o.x * o.x + o.y * o.y);
      if (valid) {
        *(unsigned*)(BR + (size_t)row * 1536 + 1024 + h * 128 + qt * 32 + c2) =
            pack2(o.x * siluf_(bflo(zc)), o.y * siluf_(bfhi(zc)));
        if (st_j == 0) STAT[(size_t)row * 32 + 16 + h * 4 + qt] = ssq;
      }
    }
    if (c + 1 < nch) { stage(Pfull, cur ^ 1); zc = Pfull.zn; }
    __syncthreads();
  };
  for (int c = 0; c < nch; c += 2) {
    body(c, P0, P1);
    if (c + 1 < nch) body(c + 1, P1, P0);
  }
#pragma unroll
  for (int i = 0; i < 8; ++i) {
    st_out[(size_t)(k0 + 2 * i) * 128 + col] = S[i].x;
    st_out[(size_t)(k0 + 2 * i + 1) * 128 + col] = S[i].y;
  }
}

__device__ __forceinline__ void scan_item(const Params& p, int l, int idx, bool is_long, char* smem) {
  const int ns = is_long ? 8 : 128;
  const int sbase = is_long ? 0 : 8;
  const int n_rw = ns * 8, n_ss = ns * 8;
  if (idx < n_rw) { scan_rwkv(p, l, sbase + idx / 8, idx % 8, smem); return; }
  idx -= n_rw;
  if (idx < n_ss) { scan_ssm(p, l, sbase + idx / 8, idx % 8, smem); return; }
  idx -= n_ss;
  { const int s = idx / 16, r = idx % 16; scan_gdn(p, l, sbase + s, r >> 2, r & 3, smem); }
}

__device__ __forceinline__ void phase_scan(const Params& p, int l, char* smem) {
  const int G = gridDim.x, bid = blockIdx.x;
  const int nlong = 256, nshort = 4096;
  int v0, stride, limit;
  if (G >= nlong + 64) {
    if (bid < nlong) { v0 = bid; stride = G; limit = nlong; }
    else { v0 = bid; stride = G - nlong; limit = nlong + nshort; }
  } else { v0 = bid; stride = G; limit = nlong + nshort; }
  for (int v = v0; v < limit; v += stride) {
    const bool is_long = v < nlong;
    scan_item(p, l, is_long ? v : v - nlong, is_long, smem);
  }
  if (l + 1 < DEPTH) {
    const int n_in = (NPAD / 64) * 16, n_lora = 16;
    int w0, wstride;
    if (G >= nlong + 64) { w0 = (bid >= nlong) ? bid - nlong : n_in + n_lora; wstride = G - nlong; }
    else { w0 = bid; wstride = G; }
    __syncthreads();
    for (int t = w0; t < n_in + n_lora; t += wstride) {
      if (t < n_in) {
        const int nt = t >> 4, kt = t & 15;
        convert_tile<true>(p.in[10] + (size_t)(l + 1) * 1024 * DPROJ, DPROJ, nt * 64, kt * 64,
                           (bf16_t*)(p.ws + OFF_WIN), 1024, smem);
      } else {
        const int u = t - n_in;
        const int which = u >> 3, nt = u & 7;
        convert_tile<false>(p.in[which ? 15 : 13] + (size_t)(l + 1) * 64 * 512, 512, nt * 64, 0,
                            (bf16_t*)(p.ws + (which ? OFF_A2T : OFF_W2T)), 64, smem);
      }
    }
  }
}

__device__ __forceinline__ void phase_post(const Params& p, int l) {
  const int tid = otid(), lane = tid & 63, wave = tid >> 6;
  bf16_t* BR = (bf16_t*)(p.out + O_YP);
  const float* STAT = (const float*)(p.ws + OFF_STAT);
  const float* snw = p.in[26] + (size_t)l * 512;
  const float* gnw = p.in[30] + (size_t)l * 128;
  for (int it = blockIdx.x; it < NT / 4; it += gridDim.x) {
    const int row = it * 4 + wave;
    float rs; const float* nw;
    if (lane < 32) {
      const int g = lane >> 4;
      const float4 a = *(const float4*)(STAT + (size_t)row * 32 + g * 4);
      const float s = (a.x + a.y) + (a.z + a.w);
      rs = rsqrtf(s * (1.f / 256.f) + 1e-5f);
      nw = snw + lane * 16;
    } else {
      const int hh = (lane - 32) >> 3;
      const float4 a = *(const float4*)(STAT + (size_t)row * 32 + 16 + hh * 4);
      const float s = (a.x + a.y) + (a.z + a.w);
      rs = rsqrtf(s * (1.f / 128.f) + 1e-6f);
      nw = gnw + ((lane - 32) & 7) * 16;
    }
    bf16_t* ptr = BR + (size_t)row * 1536 + 512 + lane * 16;
#pragma unroll
    for (int q = 0; q < 2; ++q) {
      uint4 u = *(const uint4*)(ptr + q * 8);
      const float4 w0 = *(const float4*)(nw + q * 8);
      const float4 w1 = *(const float4*)(nw + q * 8 + 4);
      u.x = pack2(bflo(u.x) * rs * w0.x, bfhi(u.x) * rs * w0.y);
      u.y = pack2(bflo(u.y) * rs * w0.z, bfhi(u.y) * rs * w0.w);
      u.z = pack2(bflo(u.z) * rs * w1.x, bfhi(u.z) * rs * w1.y);
      u.w = pack2(bflo(u.w) * rs * w1.z, bfhi(u.w) * rs * w1.w);
      *(uint4*)(ptr + q * 8) = u;
    }
  }
}

__device__ __forceinline__ void phase_gemm_merge(const Params& p, char* smem) {
  const bf16_t* BR = (const bf16_t*)(p.out + O_YP);
  const bf16_t* W = (const bf16_t*)(p.ws + OFF_WBR);
  const bf16_t* POST = (const bf16_t*)(p.ws + OFF_POST);
  bf16_t* MG = (bf16_t*)(p.ws + OFF_MERGED);
  const int tid_ = otid(); const int lane = tid_ & 63, wave = tid_ >> 6, wm = wave >> 1, wn = wave & 1;
  const int MT = NT / 128, NTn = 8;
  const int iters = tile_iters(MT, NTn);
  for (int it = 0; it < iters; ++it) {
    int mt, nt;
    if (!tile_at(it, MT, NTn, mt, nt)) break;
    f32x4 outv[4][4];
#pragma unroll
    for (int i = 0; i < 4; ++i)
#pragma unroll
      for (int j = 0; j < 4; ++j) outv[i][j] = (f32x4){0.f, 0.f, 0.f, 0.f};
    for (int b = 0; b < 3; ++b) {
      f32x4 acc[4][4];
#pragma unroll
      for (int i = 0; i < 4; ++i)
#pragma unroll
        for (int j = 0; j < 4; ++j) acc[i][j] = (f32x4){0.f, 0.f, 0.f, 0.f};
      gemm_core<false>(BR + (size_t)mt * 128 * 1536 + b * 512, 1536, W + ((size_t)b * 1024 + nt * 128) * 512, 512, 512, acc, smem);
#pragma unroll
      for (int i = 0; i < 4; ++i) {
        const int m = mt * 128 + wm * 64 + i * 16 + (lane & 15);
#pragma unroll
        for (int j = 0; j < 4; ++j) {
          const int n = nt * 128 + wn * 64 + j * 16 + (lane >> 4) * 4;
          const uint2 gz = *(const uint2*)(POST + (size_t)m * POST_W + QC_GATE + b * 1024 + n);
          outv[i][j][0] += sigmoidf_(bflo(gz.x)) * acc[i][j][0];
          outv[i][j][1] += sigmoidf_(bfhi(gz.x)) * acc[i][j][1];
          outv[i][j][2] += sigmoidf_(bflo(gz.y)) * acc[i][j][2];
          outv[i][j][3] += sigmoidf_(bfhi(gz.y)) * acc[i][j][3];
        }
      }
    }
#pragma unroll
    for (int i = 0; i < 4; ++i) {
      const int m = mt * 128 + wm * 64 + i * 16 + (lane & 15);
#pragma unroll
      for (int j = 0; j < 4; ++j) {
        const int n = nt * 128 + wn * 64 + j * 16 + (lane >> 4) * 4;
        uint2 o;
        o.x = pack2(outv[i][j][0], outv[i][j][1]);
        o.y = pack2(outv[i][j][2], outv[i][j][3]);
        *(uint2*)(MG + (size_t)m * 1024 + n) = o;
      }
    }
  }
}

__device__ __forceinline__ void phase_gemm_out(const Params& p, char* smem) {
  const bf16_t* MG = (const bf16_t*)(p.ws + OFF_MERGED);
  const bf16_t* W = (const bf16_t*)(p.ws + OFF_WOUT);
  float* X = (float*)(p.ws + OFF_X);
  const int tid_ = otid(); const int lane = tid_ & 63, wave = tid_ >> 6, wm = wave >> 1, wn = wave & 1;
  const int MT = NT / 128, NTn = 8;
  const int iters = tile_iters(MT, NTn);
  for (int it = 0; it < iters; ++it) {
    int mt, nt;
    if (!tile_at(it, MT, NTn, mt, nt)) break;
    f32x4 acc[4][4];
#pragma unroll
    for (int i = 0; i < 4; ++i)
#pragma unroll
      for (int j = 0; j < 4; ++j) acc[i][j] = (f32x4){0.f, 0.f, 0.f, 0.f};
    gemm_core<true>(MG + (size_t)mt * 128 * 1024, 1024, W + (size_t)nt * 128 * 1024, 1024, 1024, acc, smem);
#pragma unroll
    for (int i = 0; i < 4; ++i) {
      const int m = mt * 128 + wm * 64 + i * 16 + (lane & 15);
#pragma unroll
      for (int j = 0; j < 4; ++j) {
        const int n = nt * 128 + wn * 64 + j * 16 + (lane >> 4) * 4;
        float4* xp = (float4*)(X + (size_t)m * 1024 + n);
        float4 x = *xp;
        x.x += acc[i][j][0]; x.y += acc[i][j][1]; x.z += acc[i][j][2]; x.w += acc[i][j][3];
        *xp = x;
      }
    }
  }
}

__device__ __forceinline__ void phase_final(const Params& p) {
  const int tid = otid(), lane = tid & 63, wave = tid >> 6;
  const float* X = (const float*)(p.ws + OFF_X);
  const float4* nw = (const float4*)p.in[35];
  for (int it = blockIdx.x; it < NT / 4; it += gridDim.x) {
    const int row = it * 4 + wave;
    float* dst;
    if (row < NTP) {
      const int b = row / LP, t = row - b * LP;
      if (t < 16) continue;
      dst = p.out + O_YP + ((size_t)b * 2048 + (t - 16)) * 1024;
    } else {
      dst = p.out + O_YS + (size_t)(row - NTP) * 1024;
    }
    const float4* src = (const float4*)(X + (size_t)row * 1024);
    float4 v[4];
    float ss = 0.f;
#pragma unroll
    for (int i = 0; i < 4; ++i) {
      v[i] = src[lane + 64 * i];
      ss += v[i].x * v[i].x + v[i].y * v[i].y + v[i].z * v[i].z + v[i].w * v[i].w;
    }
    ss = wave_sum(ss);
    const float rs = rsqrtf(ss * (1.f / 1024.f) + 1e-6f);
#pragma unroll
    for (int i = 0; i < 4; ++i) {
      const float4 w = nw[lane + 64 * i];
      ((float4*)dst)[lane + 64 * i] = make_float4(v[i].x * rs * w.x, v[i].y * rs * w.y, v[i].z * rs * w.z, v[i].w * rs * w.w);
    }
  }
}

#define XB_TMO      128
#define XB_XCNT(j)  (256  + 64 * (j))
#define XB_XSUB(j)  (1280 + 64 * (j))
#define XB_XGEN(j)  (2304 + 64 * (j))
#define XB_TOP      3328
#define XB_TOPGEN   3392
#define XCD_BAR_WORDS 3456
#define XB_SPIN_CAP (1u << 18)
#define LAS __attribute__((address_space(3)))

__device__ __forceinline__ unsigned xb_ld(unsigned* p)              { return __hip_atomic_load(p, __ATOMIC_RELAXED, __HIP_MEMORY_SCOPE_AGENT); }
__device__ __forceinline__ unsigned xb_add(unsigned* p, unsigned v) { return __hip_atomic_fetch_add(p, v, __ATOMIC_RELAXED, __HIP_MEMORY_SCOPE_AGENT); }
__device__ __forceinline__ unsigned xb_xcc_id() { return (unsigned)__builtin_amdgcn_s_getreg((3 << 11) | 20) & 0xFu; }
#define XB_SPIN(cond, bar) do { unsigned _sp = 0; while (cond) { __builtin_amdgcn_s_sleep(1); \
    if ((++_sp & 255u) == 0u) { if (xb_ld(&(bar)[XB_TMO])) break; if (_sp > XB_SPIN_CAP) { atomicAdd(&(bar)[XB_TMO], 1u); break; } } } } while (0)

struct XcdBarrier {
    unsigned* bar; unsigned x;
    volatile LAS unsigned* st;
};

__device__ __forceinline__ XcdBarrier xcd_barrier_post(unsigned* bar, volatile LAS unsigned* st) {
    XcdBarrier b; b.bar = bar; b.x = xb_xcc_id(); b.st = st;
    if (threadIdx.x == 0) (void)xb_add(&bar[XB_XCNT(b.x)], 1u);
    return b;
}
__device__ __forceinline__ void xcd_barrier_complete(unsigned* bar, unsigned x, unsigned& nloc, unsigned& nx) {
    const unsigned G = gridDim.x * gridDim.y * gridDim.z;
    unsigned sum, cnt, mine, sp = 0u;
    for (;;) {
        sum = 0u; cnt = 0u; mine = 0u;
#pragma unroll
        for (unsigned j = 0; j < 16; ++j) { const unsigned c = xb_ld(&bar[XB_XCNT(j)]); sum += c; cnt += (c > 0u) ? 1u : 0u; mine = (j == x) ? c : mine; }
        if (sum == G) break;
        __builtin_amdgcn_s_sleep(1);
        if ((++sp & 255u) == 0u) { if (xb_ld(&bar[XB_TMO])) break; if (sp > XB_SPIN_CAP) { atomicAdd(&bar[XB_TMO], 1u); break; } }
    }
    nloc = mine > 0u ? mine : 1u; nx = cnt > 0u ? cnt : 1u;
}

__device__ __forceinline__ void xcd_barrier(const XcdBarrier& b) {
    asm volatile("s_waitcnt vmcnt(0)" ::: "memory");
    __syncthreads();
    if (threadIdx.x == 0) {
        unsigned* bar = b.bar;
        __builtin_amdgcn_s_waitcnt(0);
        unsigned nloc = b.st[0], nx = b.st[1];
        if (nloc == 0u) { xcd_barrier_complete(bar, b.x, nloc, nx); b.st[0] = nloc; b.st[1] = nx; }
        const unsigned old = xb_add(&bar[XB_XSUB(b.x)], 1u);
        const unsigned gen = old / nloc;
        if (old + 1u == (gen + 1u) * nloc) {
            __builtin_amdgcn_fence(__ATOMIC_RELEASE, "agent");
            asm volatile("s_waitcnt vmcnt(0)" ::: "memory");
            const unsigned og = xb_add(&bar[XB_TOP], 1u);
            const unsigned tg = og / nx;
            if (og + 1u == (tg + 1u) * nx) xb_add(&bar[XB_TOPGEN], 1u);
            else XB_SPIN(xb_ld(&bar[XB_TOPGEN]) == tg, bar);
            __builtin_amdgcn_fence(__ATOMIC_ACQUIRE, "agent");
            xb_add(&bar[XB_XGEN(b.x)], 1u);
            asm volatile("s_waitcnt vmcnt(0)" ::: "memory");
        } else {
            XB_SPIN(xb_ld(&bar[XB_XGEN(b.x)]) == gen, bar);
            __builtin_amdgcn_fence(__ATOMIC_ACQUIRE, "agent");
            asm volatile("s_waitcnt vmcnt(0)" ::: "memory");
        }
    }
    __syncthreads();
}


constexpr int PH_PER_LAYER = 7;
constexpr int N_PHASES = DEPTH * PH_PER_LAYER + 1;

__global__ void __launch_bounds__(256, 2) mega_kernel(Params p, int ph_begin, int ph_end) {
  __shared__ __attribute__((aligned(16))) char smem[SMEM_BYTES];
  __shared__ uint4 xb_words;
  if (threadIdx.x == 0) xb_words = make_uint4(0u, 0u, 0u, 0u);
  __syncthreads();
  const XcdBarrier xb = xcd_barrier_post((unsigned*)(p.ws + OFF_BAR), (volatile LAS unsigned*)&xb_words);
  for (int ph = ph_begin; ph < ph_end; ++ph) {
    if (ph == N_PHASES - 1) {
      phase_final(p);
    } else {
      const int l = ph / PH_PER_LAYER, k = ph - l * PH_PER_LAYER;
#ifdef DOUBLE_MASK
      const int nrep = ((DOUBLE_MASK >> k) & 1) ? 2 : 1;
      for (int rep = 0; rep < nrep; ++rep)
#endif
#ifndef PHMASK
#define PHMASK 0x7f
#endif
      switch (k) {
        case 0: if (PHMASK & 1) phase_norm_convert(p, l, smem); break;
        case 1: if (PHMASK & 2) phase_gemm_in(p, smem); break;
        case 2: if (PHMASK & 4) phase_prep(p, l, smem); break;
        case 3: if (PHMASK & 8) phase_scan(p, l, smem); break;
        case 4: if (PHMASK & 16) phase_post(p, l); break;
        case 5: if (PHMASK & 32) phase_gemm_merge(p, smem); break;
        default: if (PHMASK & 64) phase_gemm_out(p, smem); break;
      }
    }
    if (ph + 1 < ph_end) {
      if (ph == ph_begin) cg::this_grid().sync();
      else xcd_barrier(xb);
    }
  }
}

extern "C" void kernel_launch(void* const* d_in, const int* in_sizes, int n_in, void* d_out, int out_size, void* d_ws,
                              size_t ws_size, hipStream_t stream) {
  if (n_in < 36 || ws_size < WS_NEED || (size_t)out_size < O_TOTAL) {
    fprintf(stderr, "kernel_launch: unexpected sizes n_in=%d ws=%zu need=%zu out=%d\n", n_in, ws_size, WS_NEED, out_size);
    return;
  }
  static int grid_blocks = 0;
  if (!grid_blocks) {
    int dev = 0, cus = 0, per_cu = 0;
    hipGetDevice(&dev);
    hipDeviceGetAttribute(&cus, hipDeviceAttributeMultiprocessorCount, dev);
    hipOccupancyMaxActiveBlocksPerMultiprocessor(&per_cu, mega_kernel, 256, 0);
    if (per_cu > 2) per_cu = 2;
    if (per_cu < 1) per_cu = 1;
    grid_blocks = cus * per_cu;
  }
  Params p{};
  for (int i = 0; i < 36; ++i) p.in[i] = (const float*)d_in[i];
  p.out = (float*)d_out;
  p.ws = (char*)d_ws;
  (void)hipMemsetAsync((char*)d_ws + OFF_BAR, 0, BAR_BYTES, stream);
#if MULTI_LAUNCH
  for (int ph = 0; ph < N_PHASES; ++ph) {
    hipLaunchKernelGGL(mega_kernel, dim3(grid_blocks), dim3(256), 0, stream, p, ph, ph + 1);
  }
#else
  int b = 0, e = N_PHASES;
  void* args[] = {&p, &b, &e};
  hipError_t err = hipLaunchCooperativeKernel((void*)mega_kernel, dim3(grid_blocks), dim3(256), args, 0, stream);
  if (err != hipSuccess) fprintf(stderr, "cooperative launch failed: %s (grid %d)\n", hipGetErrorString(err), grid_blocks);
#endif
}
```

```cpp
#include <hip/hip_runtime.h>
#include <hip/hip_cooperative_groups.h>
#include <cstdio>
namespace cg = cooperative_groups;

#ifndef MULTI_LAUNCH
#define MULTI_LAUNCH 0
#endif

typedef unsigned short bf16_t;
using bf16x8 = __attribute__((ext_vector_type(8))) short;
using f32x4 = __attribute__((ext_vector_type(4))) float;
using u32x4 = __attribute__((ext_vector_type(4))) unsigned;

constexpr int DM = 1024;
constexpr int LP = 2064;
constexpr int NTP = 8 * LP;
constexpr int NT = NTP + 128;
constexpr int DEPTH = 4;
constexpr int DPROJ = 8848;
constexpr int PRE_W = 4352;
constexpr int POST_W = 4608;
constexpr int NPAD = PRE_W + POST_W;
constexpr int PC_RW = 0, PC_XBC = 1664, PC_QKV = 2688, PC_DT = 4224, PC_GA = 4232, PC_GB = 4236;
constexpr int QC_RWZ = 0, QC_SSMZ = 512, QC_GDNZ = 1024, QC_GATE = 1536;

constexpr size_t SZ_X = (size_t)NT * 1024 * 4;
constexpr size_t SZ_PRE = (size_t)NT * PRE_W * 2;
constexpr size_t SZ_POST = (size_t)NT * POST_W * 2;
constexpr size_t OFF_X = 0;
constexpr size_t OFF_PRE = OFF_X + SZ_X;
constexpr size_t OFF_POST = OFF_PRE + SZ_PRE;
constexpr size_t OFF_SCAN = OFF_POST + SZ_POST;
constexpr size_t OFF_RWW = OFF_SCAN;
constexpr size_t OFF_RW5 = OFF_RWW + (size_t)NT * 512 * 4;
constexpr size_t OFF_RWSC = OFF_RW5 + (size_t)NT * 5 * 512 * 2;
constexpr size_t OFF_SXBC = OFF_RWSC + (size_t)NT * 32 * 4;
constexpr size_t OFF_SDT = OFF_SXBC + (size_t)NT * 1024 * 2;
constexpr size_t OFF_GQKV = OFF_SDT + (size_t)NT * 16 * 4;
constexpr size_t OFF_GSC = OFF_GQKV + (size_t)NT * 1536 * 2;
constexpr size_t OFF_STAT = OFF_GSC + (size_t)NT * 16 * 4;
constexpr size_t OFF_WIN = OFF_STAT + (size_t)NT * 32 * 4;
constexpr size_t OFF_WBR = OFF_WIN + (size_t)NPAD * 1024 * 2;
constexpr size_t OFF_WOUT = OFF_WBR + (size_t)3 * 1024 * 512 * 2;
constexpr size_t OFF_W2T = OFF_WOUT + (size_t)1024 * 1024 * 2;
constexpr size_t OFF_A2T = OFF_W2T + (size_t)512 * 64 * 2;
constexpr size_t OFF_BAR = OFF_A2T + (size_t)512 * 64 * 2;
constexpr size_t BAR_BYTES = 3456 * 4;
constexpr size_t OFF_FLAGS = OFF_BAR + 16384;
constexpr size_t WS_NEED = OFF_FLAGS + 1024;
constexpr size_t OFF_H = OFF_SCAN;
constexpr size_t OFF_MERGED = OFF_PRE + (size_t)NT * 1536 * 2;

constexpr size_t O_YP = 0;
constexpr size_t O_YS = O_YP + (size_t)8 * 2048 * 1024;
constexpr size_t O_P_WKV = O_YS + (size_t)128 * 1024;
constexpr size_t O_P_SHIFT = O_P_WKV + (size_t)4 * 8 * 8 * 64 * 64;
constexpr size_t O_P_SSM = O_P_SHIFT + (size_t)4 * 8 * 1664;
constexpr size_t O_P_SCONV = O_P_SSM + (size_t)4 * 8 * 8 * 64 * 128;
constexpr size_t O_P_GDN = O_P_SCONV + (size_t)4 * 8 * 3 * 1024;
constexpr size_t O_P_GCONV = O_P_GDN + (size_t)4 * 8 * 4 * 128 * 128;
constexpr size_t O_S_WKV = O_P_GCONV + (size_t)4 * 8 * 3 * 1536;
constexpr size_t O_S_SHIFT = O_S_WKV + (size_t)4 * 128 * 8 * 64 * 64;
constexpr size_t O_S_SSM = O_S_SHIFT + (size_t)4 * 128 * 1664;
constexpr size_t O_S_SCONV = O_S_SSM + (size_t)4 * 128 * 8 * 64 * 128;
constexpr size_t O_S_GDN = O_S_SCONV + (size_t)4 * 128 * 3 * 1024;
constexpr size_t O_S_GCONV = O_S_GDN + (size_t)4 * 128 * 4 * 128 * 128;
constexpr size_t O_TOTAL = O_S_GCONV + (size_t)4 * 128 * 3 * 1536;

constexpr int SMEM_BYTES = 73728;
constexpr int LDS_STRIDE = 64;

struct Params {
  const float* in[36];
  float* out;
  char* ws;
};

__device__ __forceinline__ bf16_t f2bf(float f) {
  unsigned u = __float_as_uint(f);
  u += 0x7fffu + ((u >> 16) & 1u);
  return (bf16_t)(u >> 16);
}
__device__ __forceinline__ float bf2f(bf16_t h) { return __uint_as_float(((unsigned)h) << 16); }
__device__ __forceinline__ unsigned pack2(float a, float b) { return (unsigned)f2bf(a) | ((unsigned)f2bf(b) << 16); }
__device__ __forceinline__ float bflo(unsigned u) { return __uint_as_float(u << 16); }
__device__ __forceinline__ float bfhi(unsigned u) { return __uint_as_float(u & 0xffff0000u); }
__device__ __forceinline__ float rbf(float f) { return bf2f(f2bf(f)); }

__device__ __forceinline__ int otid() { int t = threadIdx.x; asm volatile("" : "+v"(t)); return t; }
template <int CTRL>
__device__ __forceinline__ float dppf(float v) {
  return __int_as_float(__builtin_amdgcn_update_dpp(0, __float_as_int(v), CTRL, 0xF, 0xF, true));
}
__device__ __forceinline__ float red4(float v) { v += dppf<0xB1>(v); v += dppf<0x4E>(v); return v; }
__device__ __forceinline__ float red8(float v) { v = red4(v); v += dppf<0x141>(v); return v; }
__device__ __forceinline__ float red16(float v) { v = red8(v); v += dppf<0x140>(v); return v; }
__device__ __forceinline__ float wave_sum(float v) {
  v = red16(v);
  const int iv = __float_as_int(v);
  const float r0 = __int_as_float(__builtin_amdgcn_readlane(iv, 0));
  const float r1 = __int_as_float(__builtin_amdgcn_readlane(iv, 16));
  const float r2 = __int_as_float(__builtin_amdgcn_readlane(iv, 32));
  const float r3 = __int_as_float(__builtin_amdgcn_readlane(iv, 48));
  return (r0 + r1) + (r2 + r3);
}
__device__ __forceinline__ float frcp_(float x) { return __builtin_amdgcn_rcpf(x); }
__device__ __forceinline__ float sigmoidf_(float x) { return frcp_(1.f + __expf(-x)); }
__device__ __forceinline__ float siluf_(float x) { return x * frcp_(1.f + __expf(-x)); }
__device__ __forceinline__ float softplusf_(float x) { return fmaxf(x, 0.f) + __logf(1.f + __expf(-fabsf(x))); }
__device__ __forceinline__ float ftanh_(float x) {
  const float e = __expf(-2.f * fabsf(x));
  const float t = (1.f - e) * frcp_(1.f + e);
  return x < 0.f ? -t : t;
}

__device__ __forceinline__ void row_to_seq(int row, int& seq, int& t) {
  if (row < NTP) { seq = row / LP; t = row - seq * LP; } else { seq = 8 + (row - NTP); t = 0; }
}

__device__ __forceinline__ bool tile_at(int it, int MT, int NTn, int& mt, int& nt) {
  const int G = gridDim.x;
  const int nx = (G % 8 == 0) ? 8 : 1;
  const int x = blockIdx.x % nx, j = blockIdx.x / nx, nloc = G / nx;
  const int ch = x + nx * it;
  const int q = ch * nloc + j;
  if (q >= MT * NTn) return false;
  const int gs = 8 * NTn;
  const int g = q / gs, rem = q - g * gs;
  const int gsz = min(8, MT - g * 8);
  nt = rem / gsz;
  mt = g * 8 + (rem - nt * gsz);
  return true;
}
__device__ __forceinline__ int tile_iters(int MT, int NTn) {
  const int G = gridDim.x;
  const int nx = (G % 8 == 0) ? 8 : 1;
  const int nloc = G / nx;
  const int nchunks = (MT * NTn + nloc - 1) / nloc;
  return (nchunks + nx - 1) / nx;
}

__device__ __forceinline__ void mma_ktile(const bf16_t* cA, const bf16_t* cB, int fo0, int fo1, f32x4 (&acc)[4][4]) {
#pragma unroll
  for (int ks = 0; ks < 2; ++ks) {
    const int fo = ks ? fo1 : fo0;
    bf16x8 af[4], bfr[4];
#pragma unroll
    for (int i = 0; i < 4; ++i) af[i] = *(const bf16x8*)(cA + i * 16 * LDS_STRIDE + fo);
#pragma unroll
    for (int j = 0; j < 4; ++j) bfr[j] = *(const bf16x8*)(cB + j * 16 * LDS_STRIDE + fo);
#pragma unroll
    for (int i = 0; i < 4; ++i)
#pragma unroll
      for (int j = 0; j < 4; ++j)
        acc[i][j] = __builtin_amdgcn_mfma_f32_16x16x32_bf16(bfr[j], af[i], acc[i][j], 0, 0, 0);
  }
}

template <bool DEEP>
__device__ __forceinline__ void gemm_core(const bf16_t* __restrict__ A, int lda, const bf16_t* __restrict__ Bt, int ldb,
                                          int K, f32x4 (&acc)[4][4], char* smem) {
  bf16_t* sA = (bf16_t*)smem;
  bf16_t* sB = sA + 2 * 128 * LDS_STRIDE;
  const int tid = otid(), lane = tid & 63, wave = tid >> 6;
  const int wm = wave >> 1, wn = wave & 1;
  const int lr = tid >> 3, lc = (tid & 7) * 8;
  const bf16_t* ap = A + (size_t)lr * lda + lc;
  const bf16_t* bp = Bt + (size_t)lr * ldb + lc;
  const int nk = K >> 6;
  const int fr = lane & 15, fq = (lane >> 4) * 8;
  const int rswz = (fr >> 1) & 7, wswz = (lr >> 1) & 7;
  const int fo0 = (((lane >> 4)) ^ rswz) * 8, fo1 = ((4 + (lane >> 4)) ^ rswz) * 8;
  const bf16_t* cA0 = sA + (wm * 64 + fr) * LDS_STRIDE;
  const bf16_t* cB0 = sB + (wn * 64 + fr) * LDS_STRIDE;
  bf16_t* wA = sA + lr * LDS_STRIDE + (((tid & 7) ^ wswz) * 8);
  bf16_t* wB = sB + lr * LDS_STRIDE + (((tid & 7) ^ wswz) * 8);
  constexpr int BUF = 128 * LDS_STRIDE;
#define GLOAD(RA, RB, kt_)                                                         \
  _Pragma("unroll") for (int i = 0; i < 4; ++i) {                                  \
    RA[i] = *(const u32x4*)(ap + (size_t)(32 * i) * lda + ((kt_) << 6));           \
    RB[i] = *(const u32x4*)(bp + (size_t)(32 * i) * ldb + ((kt_) << 6));           \
  }
#define SWRITE(RA, RB, buf_)                                                       \
  _Pragma("unroll") for (int i = 0; i < 4; ++i) {                                  \
    *(u32x4*)(wA + (buf_) * BUF + 32 * i * LDS_STRIDE) = RA[i];                    \
    *(u32x4*)(wB + (buf_) * BUF + 32 * i * LDS_STRIDE) = RB[i];                    \
  }
  u32x4 ra0[4], rb0[4];
  GLOAD(ra0, rb0, 0);
  if (DEEP) {
    u32x4 ra1[4], rb1[4];
    GLOAD(ra1, rb1, 1);
    __syncthreads();
    SWRITE(ra0, rb0, 0);
    __syncthreads();
    for (int kt = 0; kt < nk; kt += 2) {
      { const int k2 = min(kt + 2, nk - 1); GLOAD(ra0, rb0, k2); }
      mma_ktile(cA0, cB0, fo0, fo1, acc);
      SWRITE(ra1, rb1, 1);
      __syncthreads();
      { const int k3 = min(kt + 3, nk - 1); GLOAD(ra1, rb1, k3); }
      mma_ktile(cA0 + BUF, cB0 + BUF, fo0, fo1, acc);
      if (kt + 2 < nk) { SWRITE(ra0, rb0, 0); }
      __syncthreads();
    }
  } else {
    __syncthreads();
    SWRITE(ra0, rb0, 0);
    __syncthreads();
    for (int kt = 0; kt < nk; ++kt) {
      const int cur = kt & 1;
      { const int k1 = min(kt + 1, nk - 1); GLOAD(ra0, rb0, k1); }
      mma_ktile(cA0 + cur * BUF, cB0 + cur * BUF, fo0, fo1, acc);
      if (kt + 1 < nk) { SWRITE(ra0, rb0, cur ^ 1); }
      __syncthreads();
    }
  }
#undef GLOAD
#undef SWRITE
}

__device__ __forceinline__ void gemm_core_big(const bf16_t* __restrict__ A, int lda, const bf16_t* __restrict__ Bt, int ldb,
                                              int K, f32x4 (&acc)[8][4], char* smem) {
  bf16_t* sA = (bf16_t*)smem;
  bf16_t* sB = sA + 256 * LDS_STRIDE;
  const int tid = otid(), lane = tid & 63, wave = tid >> 6;
  const int wm = wave >> 1, wn = wave & 1;
  const int lr = tid >> 3, lc = (tid & 7) * 8;
  const bf16_t* ap = A + (size_t)lr * lda + lc;
  const bf16_t* bp = Bt + (size_t)lr * ldb + lc;
  const int nk = K >> 6;
  const int fr = lane & 15, fq = (lane >> 4) * 8;
  const int rswz = (fr >> 1) & 7, wswz = (lr >> 1) & 7;
  const int fo0 = (((lane >> 4)) ^ rswz) * 8, fo1 = ((4 + (lane >> 4)) ^ rswz) * 8;
  const bf16_t* cA = sA + (wm * 128 + fr) * LDS_STRIDE;
  const bf16_t* cB = sB + (wn * 64 + fr) * LDS_STRIDE;
  bf16_t* wA = sA + lr * LDS_STRIDE + (((tid & 7) ^ wswz) * 8);
  bf16_t* wB = sB + lr * LDS_STRIDE + (((tid & 7) ^ wswz) * 8);
  u32x4 ra[8], rb[4];
#pragma unroll
  for (int i = 0; i < 8; ++i) ra[i] = *(const u32x4*)(ap + (size_t)(32 * i) * lda);
#pragma unroll
  for (int i = 0; i < 4; ++i) rb[i] = *(const u32x4*)(bp + (size_t)(32 * i) * ldb);
  for (int kt = 0; kt < nk; ++kt) {
    __syncthreads();
#pragma unroll
    for (int i = 0; i < 8; ++i) *(u32x4*)(wA + 32 * i * LDS_STRIDE) = ra[i];
#pragma unroll
    for (int i = 0; i < 4; ++i) *(u32x4*)(wB + 32 * i * LDS_STRIDE) = rb[i];
    __syncthreads();
    {
      const int k1 = min(kt + 1, nk - 1) << 6;
#pragma unroll
      for (int i = 0; i < 8; ++i) ra[i] = *(const u32x4*)(ap + (size_t)(32 * i) * lda + k1);
#pragma unroll
      for (int i = 0; i < 4; ++i) rb[i] = *(const u32x4*)(bp + (size_t)(32 * i) * ldb + k1);
    }
#pragma unroll
    for (int ks = 0; ks < 2; ++ks) {
      const int fo = ks ? fo1 : fo0;
      bf16x8 bfr[4];
#pragma unroll
      for (int j = 0; j < 4; ++j) bfr[j] = *(const bf16x8*)(cB + j * 16 * LDS_STRIDE + fo);
#pragma unroll
      for (int i = 0; i < 8; ++i) {
        const bf16x8 af = *(const bf16x8*)(cA + i * 16 * LDS_STRIDE + fo);
#pragma unroll
        for (int j = 0; j < 4; ++j)
          acc[i][j] = __builtin_amdgcn_mfma_f32_16x16x32_bf16(bfr[j], af, acc[i][j], 0, 0, 0);
      }
    }
  }
}

__device__ __forceinline__ int inproj_src_col(int np) {
  if (np < PRE_W) {
    if (np < 1664) return np;
    if (np < 2688) return np - 1664 + 2688;
    if (np < 4224) return np - 2688 + 3720;
    if (np < 4232) return np - 4224 + 3712;
    if (np < 4240) return np - 4232 + 5768;
    return -1;
  }
  const int j = np - PRE_W;
  if (j < 512) return 1664 + j;
  if (j < 1024) return 2176 + (j - 512);
  if (j < 1536) return 5256 + (j - 1024);
  return 5776 + (j - 1536);
}

template <bool INPROJ>
__device__ __forceinline__ void convert_tile(const float* __restrict__ src, int src_ld, int n0, int k0,
                                             bf16_t* __restrict__ dst, int dst_ld, char* smem) {
  float* tile = (float*)smem;
  const int tid = otid();
  const int nn = tid & 63;
  int sc = INPROJ ? inproj_src_col(n0 + nn) : (n0 + nn);
#pragma unroll
  for (int i = 0; i < 16; ++i) {
    const int kk = (tid >> 6) + 4 * i;
    float v = 0.f;
    if (sc >= 0) v = src[(size_t)(k0 + kk) * src_ld + sc];
    tile[kk * 65 + nn] = v;
  }
  __syncthreads();
#pragma unroll
  for (int i = 0; i < 8; ++i) {
    const int n2 = (tid >> 5) + 8 * i;
    const int k2 = (tid & 31) * 2;
    const unsigned pk = pack2(tile[k2 * 65 + n2], tile[(k2 + 1) * 65 + n2]);
    *(unsigned*)(dst + (size_t)(n0 + n2) * dst_ld + k0 + k2) = pk;
  }
  __syncthreads();
}

__device__ __forceinline__ void phase_norm_convert(const Params& p, int l, char* smem) {
  const int tid = otid(), lane = tid & 63, wave = tid >> 6;
  float* X = (float*)(p.ws + OFF_X);
  bf16_t* H = (bf16_t*)(p.ws + OFF_H);
  const int n_row_items = NT / 4;
  const int n_in = (NPAD / 64) * 16, n_br = 3 * 16 * 8, n_out = 16 * 16;
  const int n_lora = 16;
  const int total = n_row_items + n_in + n_br + n_out + n_lora;
  for (int it = blockIdx.x; it < total; it += gridDim.x) {
    if (it < n_row_items) {
      const int row = it * 4 + wave;
      const float* src;
      if (l == 0) {
        if (row < NTP) {
          const int b = row / LP, t = row - b * LP;
          src = (t < 16) ? (p.in[8] + (size_t)t * 1024) : (p.in[0] + ((size_t)b * 2048 + (t - 16)) * 1024);
        } else {
          src = p.in[1] + (size_t)(row - NTP) * 1024;
        }
      } else {
        src = X + (size_t)row * 1024;
      }
      float4 v[4];
      float ss = 0.f;
#pragma unroll
      for (int i = 0; i < 4; ++i) {
        v[i] = ((const float4*)src)[lane + 64 * i];
        ss += v[i].x * v[i].x + v[i].y * v[i].y + v[i].z * v[i].z + v[i].w * v[i].w;
      }
      ss = wave_sum(ss);
      const float rs = rsqrtf(ss * (1.f / 1024.f) + 1e-6f);
      const float4* nw = (const float4*)(p.in[9] + (size_t)l * 1024);
#pragma unroll
      for (int i = 0; i < 4; ++i) {
        if (l == 0) ((float4*)(X + (size_t)row * 1024))[lane + 64 * i] = v[i];
        const float4 w = nw[lane + 64 * i];
        uint2 o;
        o.x = pack2(v[i].x * rs * w.x, v[i].y * rs * w.y);
        o.y = pack2(v[i].z * rs * w.z, v[i].w * rs * w.w);
        *(uint2*)(H + (size_t)row * 1024 + (lane + 64 * i) * 4) = o;
      }
    } else {
      int t = it - n_row_items;
      if (t < n_in) {
        if (l == 0) {
          const int nt = t >> 4, kt = t & 15;
          convert_tile<true>(p.in[10] + (size_t)l * 1024 * DPROJ, DPROJ, nt * 64, kt * 64,
                             (bf16_t*)(p.ws + OFF_WIN), 1024, smem);
        }
      } else if (t < n_in + n_br) {
        t -= n_in;
        const int b = t / 128, r = t - b * 128;
        const int nt = r >> 3, kt = r & 7;
        convert_tile<false>(p.in[31 + b] + (size_t)l * 512 * 1024, 1024, nt * 64, kt * 64,
                            (bf16_t*)(p.ws + OFF_WBR) + (size_t)b * 1024 * 512, 512, smem);
      } else if (t < n_in + n_br + n_out) {
        t -= n_in + n_br;
        const int nt = t >> 4, kt = t & 15;
        convert_tile<false>(p.in[34] + (size_t)l * 1024 * 1024, 1024, nt * 64, kt * 64,
                            (bf16_t*)(p.ws + OFF_WOUT), 1024, smem);
      } else {
        t -= n_in + n_br + n_out;
        {
          const int which = t >> 3, nt = t & 7;
          convert_tile<false>(p.in[which ? 15 : 13] + (size_t)l * 64 * 512, 512, nt * 64, 0,
                              (bf16_t*)(p.ws + (which ? OFF_A2T : OFF_W2T)), 64, smem);
        }
      }
    }
  }
}

__device__ __forceinline__ void phase_gemm_in(const Params& p, char* smem) {
  const bf16_t* H = (const bf16_t*)(p.ws + OFF_H);
  const bf16_t* W = (const bf16_t*)(p.ws + OFF_WIN);
  bf16_t* PRE = (bf16_t*)(p.ws + OFF_PRE);
  bf16_t* POST = (bf16_t*)(p.ws + OFF_POST);
  const int tid_ = otid(); const int lane = tid_ & 63, wave = tid_ >> 6, wm = wave >> 1, wn = wave & 1;
  const int MT = NT / 256, NTn = NPAD / 128;
  const int iters = tile_iters(MT, NTn);
  for (int it = 0; it < iters; ++it) {
    int mt, nt;
    if (!tile_at(it, MT, NTn, mt, nt)) break;
    f32x4 acc[8][4];
#pragma unroll
    for (int i = 0; i < 8; ++i)
#pragma unroll
      for (int j = 0; j < 4; ++j) acc[i][j] = (f32x4){0.f, 0.f, 0.f, 0.f};
    gemm_core_big(H + (size_t)mt * 256 * 1024, 1024, W + (size_t)nt * 128 * 1024, 1024, 1024, acc, smem);
    bf16_t* dst; int ldd, ncol0;
    if (nt < PRE_W / 128) { dst = PRE; ldd = PRE_W; ncol0 = nt * 128; }
    else { dst = POST; ldd = POST_W; ncol0 = (nt - PRE_W / 128) * 128; }
#pragma unroll
    for (int i = 0; i < 8; ++i) {
      const int m = mt * 256 + wm * 128 + i * 16 + (lane & 15);
#pragma unroll
      for (int j = 0; j < 4; ++j) {
        const int n = ncol0 + wn * 64 + j * 16 + (lane >> 4) * 4;
        uint2 o;
        o.x = pack2(acc[i][j][0], acc[i][j][1]);
        o.y = pack2(acc[i][j][2], acc[i][j][3]);
        *(uint2*)(dst + (size_t)m * ldd + n) = o;
      }
    }
  }
}

__device__ __forceinline__ void prep_rwkv(const Params& p, int l, int item, char* smem) {
  bf16_t* sA = (bf16_t*)smem;
  float* sW = (float*)(smem + 4352);
  float* sAs = sW + 16 * 516;
  const int tid = otid(), lane = tid & 63, wave = tid >> 6;
  const int row0 = item * 16;
  const bf16_t* PRE = (const bf16_t*)(p.ws + OFF_PRE);
  const float* mu = p.in[11] + (size_t)l * 1664;
  const float* shift_in = p.in[3] + (size_t)l * 128 * 1664;
  float* RWW = (float*)(p.ws + OFF_RWW);
  bf16_t* RW5 = (bf16_t*)(p.ws + OFF_RW5);
  float* RWSC = (float*)(p.ws + OFF_RWSC);
  const bf16_t* W2T = (const bf16_t*)(p.ws + OFF_W2T);
  const bf16_t* A2T = (const bf16_t*)(p.ws + OFF_A2T);

  __syncthreads();
  {
    const int tok = tid >> 4, c8 = (tid & 15) * 8;
    const int row = row0 + tok;
    int seq, t; row_to_seq(row, seq, t);
    const int col = 1536 + c8;
    const u32x4 pv = *(const u32x4*)(PRE + (size_t)row * PRE_W + col);
    float x[8], pr[8];
    x[0] = bflo(pv.x); x[1] = bfhi(pv.x); x[2] = bflo(pv.y); x[3] = bfhi(pv.y);
    x[4] = bflo(pv.z); x[5] = bfhi(pv.z); x[6] = bflo(pv.w); x[7] = bfhi(pv.w);
    if (t > 0) {
      const u32x4 pp = *(const u32x4*)(PRE + (size_t)(row - 1) * PRE_W + col);
      pr[0] = bflo(pp.x); pr[1] = bfhi(pp.x); pr[2] = bflo(pp.y); pr[3] = bfhi(pp.y);
      pr[4] = bflo(pp.z); pr[5] = bfhi(pp.z); pr[6] = bflo(pp.w); pr[7] = bfhi(pp.w);
    } else if (seq >= 8) {
      const float4 h0 = *(const float4*)(shift_in + (size_t)(seq - 8) * 1664 + col);
      const float4 h1 = *(const float4*)(shift_in + (size_t)(seq - 8) * 1664 + col + 4);
      pr[0] = h0.x; pr[1] = h0.y; pr[2] = h0.z; pr[3] = h0.w; pr[4] = h1.x; pr[5] = h1.y; pr[6] = h1.z; pr[7] = h1.w;
    } else {
#pragma unroll
      for (int j = 0; j < 8; ++j) pr[j] = 0.f;
    }
    const float4 m0 = *(const float4*)(mu + col), m1 = *(const float4*)(mu + col + 4);
    const float mm[8] = {m0.x, m0.y, m0.z, m0.w, m1.x, m1.y, m1.z, m1.w};
    float u[8];
#pragma unroll
    for (int j = 0; j < 8; ++j) {
      u[j] = x[j] + (pr[j] - x[j]) * mm[j];
      if (c8 < 64) u[j] = ftanh_(u[j]);
    }
    u32x4 o;
    o.x = pack2(u[0], u[1]); o.y = pack2(u[2], u[3]); o.z = pack2(u[4], u[5]); o.w = pack2(u[6], u[7]);
    *(u32x4*)(sA + tok * 136 + c8) = o;
  }
  __syncthreads();
  {
    const int fr = lane & 15, fq = (lane >> 4) * 8;
    bf16x8 atw[2], aad[2];
#pragma unroll
    for (int ks = 0; ks < 2; ++ks) {
      atw[ks] = *(const bf16x8*)(sA + fr * 136 + ks * 32 + fq);
      aad[ks] = *(const bf16x8*)(sA + fr * 136 + 64 + ks * 32 + fq);
    }
    const float* w0 = p.in[12] + (size_t)l * 512;
    const float* a0 = p.in[14] + (size_t)l * 512;
#pragma unroll
    for (int jt = 0; jt < 8; ++jt) {
      const int n = wave * 128 + jt * 16 + fr;
      f32x4 cw = (f32x4){0.f, 0.f, 0.f, 0.f}, ca = (f32x4){0.f, 0.f, 0.f, 0.f};
#pragma unroll
      for (int ks = 0; ks < 2; ++ks) {
        const bf16x8 bw = *(const bf16x8*)(W2T + (size_t)n * 64 + ks * 32 + fq);
        const bf16x8 ba = *(const bf16x8*)(A2T + (size_t)n * 64 + ks * 32 + fq);
        cw = __builtin_amdgcn_mfma_f32_16x16x32_bf16(atw[ks], bw, cw, 0, 0, 0);
        ca = __builtin_amdgcn_mfma_f32_16x16x32_bf16(aad[ks], ba, ca, 0, 0, 0);
      }
      const float w0v = w0[n], a0v = a0[n];
#pragma unroll
      for (int r = 0; r < 4; ++r) {
        const int tok = (lane >> 4) * 4 + r;
        const float wl = w0v + cw[r];
        const float wv = -softplusf_(-wl) - 0.5f;
        sW[tok * 516 + n] = __expf(-__expf(wv));
        sAs[tok * 516 + n] = sigmoidf_(a0v + ca[r]);
      }
    }
  }
  __syncthreads();
  {
    const int chunk = tid & 127, ch4 = chunk * 4, head = chunk >> 4;
    const float4 mur = *(const float4*)(mu + ch4), muk = *(const float4*)(mu + 512 + ch4), muv = *(const float4*)(mu + 1024 + ch4);
    const float4 kkc = *(const float4*)(p.in[16] + (size_t)l * 512 + ch4);
    const float4 kac = *(const float4*)(p.in[17] + (size_t)l * 512 + ch4);
    const float4 rkc = *(const float4*)(p.in[18] + (size_t)l * 512 + ch4);
#pragma unroll
    for (int i = 0; i < 8; ++i) {
      const int tok = (tid >> 7) + 2 * i;
      const int row = row0 + tok;
      int seq, t; row_to_seq(row, seq, t);
      const uint2 pr_ = *(const uint2*)(PRE + (size_t)row * PRE_W + ch4);
      const uint2 pk_ = *(const uint2*)(PRE + (size_t)row * PRE_W + 512 + ch4);
      const uint2 pv_ = *(const uint2*)(PRE + (size_t)row * PRE_W + 1024 + ch4);
      float4 qr, qk, qv;
      if (t > 0) {
        const uint2 a_ = *(const uint2*)(PRE + (size_t)(row - 1) * PRE_W + ch4);
        const uint2 b_ = *(const uint2*)(PRE + (size_t)(row - 1) * PRE_W + 512 + ch4);
        const uint2 c_ = *(const uint2*)(PRE + (size_t)(row - 1) * PRE_W + 1024 + ch4);
        qr = make_float4(bflo(a_.x), bfhi(a_.x), bflo(a_.y), bfhi(a_.y));
        qk = make_float4(bflo(b_.x), bfhi(b_.x), bflo(b_.y), bfhi(b_.y));
        qv = make_float4(bflo(c_.x), bfhi(c_.x), bflo(c_.y), bfhi(c_.y));
      } else if (seq >= 8) {
        const float* sh = shift_in + (size_t)(seq - 8) * 1664;
        qr = *(const float4*)(sh + ch4); qk = *(const float4*)(sh + 512 + ch4); qv = *(const float4*)(sh + 1024 + ch4);
      } else {
        qr = qk = qv = make_float4(0.f, 0.f, 0.f, 0.f);
      }
      const float4 dec = *(const float4*)(sW + tok * 516 + ch4);
      const float4 as = *(const float4*)(sAs + tok * 516 + ch4);
      const float pr4[4] = {bflo(pr_.x), bfhi(pr_.x), bflo(pr_.y), bfhi(pr_.y)};
      const float pk4[4] = {bflo(pk_.x), bfhi(pk_.x), bflo(pk_.y), bfhi(pk_.y)};
      const float pv4[4] = {bflo(pv_.x), bfhi(pv_.x), bflo(pv_.y), bfhi(pv_.y)};
      const float qr4[4] = {qr.x, qr.y, qr.z, qr.w}, qk4[4] = {qk.x, qk.y, qk.z, qk.w}, qv4[4] = {qv.x, qv.y, qv.z, qv.w};
      const float mr4[4] = {mur.x, mur.y, mur.z, mur.w}, mk4[4] = {muk.x, muk.y, muk.z, muk.w}, mv4[4] = {muv.x, muv.y, muv.z, muv.w};
      const float kk4[4] = {kkc.x, kkc.y, kkc.z, kkc.w}, ka4[4] = {kac.x, kac.y, kac.z, kac.w}, rk4[4] = {rkc.x, rkc.y, rkc.z, rkc.w};
      const float de4[4] = {dec.x, dec.y, dec.z, dec.w}, as4[4] = {as.x, as.y, as.z, as.w};
      float r[4], kx[4], v[4], kkr[4];
      float ssq = 0.f;
#pragma unroll
      for (int j = 0; j < 4; ++j) {
        r[j] = pr4[j] + (qr4[j] - pr4[j]) * mr4[j];
        kx[j] = pk4[j] + (qk4[j] - pk4[j]) * mk4[j];
        v[j] = pv4[j] + (qv4[j] - pv4[j]) * mv4[j];
        kkr[j] = kx[j] * kk4[j];
        ssq += kkr[j] * kkr[j];
      }
      ssq = red16(ssq);
      const float rn = rsqrtf(ssq + 1e-6f);
      float fA[4], fWR[4], fB[4], fK[4];
      float br = 0.f, kr = 0.f, rks = 0.f;
#pragma unroll
      for (int j = 0; j < 4; ++j) {
        const float kk = kkr[j] * rn;
        const float kp = kx[j] * (1.f + (as4[j] - 1.f) * ka4[j]);
        fA[j] = -kk; fWR[j] = de4[j] * r[j]; fB[j] = kk * as4[j]; fK[j] = kp;
        br += rbf(fB[j]) * r[j];
        kr += rbf(fK[j]) * r[j];
        rks += r[j] * kp * rk4[j];
      }
      br = red16(br); kr = red16(kr); rks = red16(rks);
      *(float4*)(RWW + (size_t)row * 512 + ch4) = dec;
      bf16_t* d5 = RW5 + (size_t)row * 5 * 512 + ch4;
      *(uint2*)(d5) = make_uint2(pack2(fA[0], fA[1]), pack2(fA[2], fA[3]));
      *(uint2*)(d5 + 512) = make_uint2(pack2(fWR[0], fWR[1]), pack2(fWR[2], fWR[3]));
      *(uint2*)(d5 + 1024) = make_uint2(pack2(fB[0], fB[1]), pack2(fB[2], fB[3]));
      *(uint2*)(d5 + 1536) = make_uint2(pack2(fK[0], fK[1]), pack2(fK[2], fK[3]));
      *(uint2*)(d5 + 2048) = make_uint2(pack2(v[0], v[1]), pack2(v[2], v[3]));
      if ((chunk & 15) == 0) *(float4*)(RWSC + ((size_t)row * 8 + head) * 4) = make_float4(br, kr, rks, 0.f);
    }
  }
  if (row0 >= NTP) {
    for (int idx = tid; idx < 16 * 416; idx += 256) {
      const int tok = idx / 416, c4 = (idx - tok * 416) * 4;
      const int row = row0 + tok;
      const uint2 u = *(const uint2*)(PRE + (size_t)row * PRE_W + c4);
      *(float4*)(p.out + O_S_SHIFT + ((size_t)l * 128 + (row - NTP)) * 1664 + c4) =
          make_float4(bflo(u.x), bfhi(u.x), bflo(u.y), bfhi(u.y));
    }
  } else {
    const int seq = row0 / LP, t0 = row0 - seq * LP;
    if (t0 + 16 == LP) {
      const int row = row0 + 15;
      for (int c4 = tid * 4; c4 < 1664; c4 += 1024) {
        const uint2 u = *(const uint2*)(PRE + (size_t)row * PRE_W + c4);
        *(float4*)(p.out + O_P_SHIFT + ((size_t)l * 8 + seq) * 1664 + c4) = make_float4(bflo(u.x), bfhi(u.x), bflo(u.y), bfhi(u.y));
      }
    }
  }
}

__device__ __forceinline__ void prep_conv_token(const Params& p, int l, int row, int tid, int lane, int wave) {
  const bf16_t* PRE = (const bf16_t*)(p.ws + OFF_PRE);
  bf16_t* SXBC = (bf16_t*)(p.ws + OFF_SXBC);
  float* SDT = (float*)(p.ws + OFF_SDT);
  bf16_t* GQKV = (bf16_t*)(p.ws + OFF_GQKV);
  float* GSC = (float*)(p.ws + OFF_GSC);
  const float* scw = p.in[21] + (size_t)l * 4 * 1024;
  const float* scb = p.in[22] + (size_t)l * 1024;
  const float* gcw = p.in[27] + (size_t)l * 4 * 1536;
  const float* shist = p.in[5] + (size_t)l * 128 * 3 * 1024;
  const float* ghist = p.in[7] + (size_t)l * 128 * 3 * 1536;
  const int b = row - NTP;
  {
    const int c = tid * 4;
    float acc[4] = {scb[c], scb[c + 1], scb[c + 2], scb[c + 3]};
    float cur[4];
    {
      const uint2 u = *(const uint2*)(PRE + (size_t)row * PRE_W + PC_XBC + c);
      cur[0] = bflo(u.x); cur[1] = bfhi(u.x); cur[2] = bflo(u.y); cur[3] = bfhi(u.y);
      const float4 w = *(const float4*)(scw + (size_t)3 * 1024 + c);
      acc[0] += cur[0] * w.x; acc[1] += cur[1] * w.y; acc[2] += cur[2] * w.z; acc[3] += cur[3] * w.w;
    }
    float* o2 = p.out + O_S_SCONV + ((size_t)l * 128 + b) * 3 * 1024;
#pragma unroll
    for (int j = 0; j < 3; ++j) {
      const float4 h = *(const float4*)(shist + ((size_t)b * 3 + j) * 1024 + c);
      const float4 w = *(const float4*)(scw + (size_t)j * 1024 + c);
      acc[0] += h.x * w.x; acc[1] += h.y * w.y; acc[2] += h.z * w.z; acc[3] += h.w * w.w;
      if (j > 0) *(float4*)(o2 + (j - 1) * 1024 + c) = h;
    }
    *(float4*)(o2 + 2 * 1024 + c) = make_float4(cur[0], cur[1], cur[2], cur[3]);
    uint2 o;
    o.x = pack2(siluf_(acc[0]), siluf_(acc[1]));
    o.y = pack2(siluf_(acc[2]), siluf_(acc[3]));
    *(uint2*)(SXBC + (size_t)row * 1024 + c) = o;
    if (tid < 8) {
      const float dtv = softplusf_(bf2f(PRE[(size_t)row * PRE_W + PC_DT + tid]) + p.in[23][l * 8 + tid]);
      const float a = -__expf(p.in[24][l * 8 + tid]);
      SDT[(size_t)row * 16 + tid * 2 + 0] = dtv;
      SDT[(size_t)row * 16 + tid * 2 + 1] = __expf(dtv * a);
    }
  }
  {
    float val[3][2];
    float* o2 = p.out + O_S_GCONV + ((size_t)l * 128 + b) * 3 * 1536;
#pragma unroll
    for (int i = 0; i < 3; ++i) {
      const int c = 2 * tid + 512 * i;
      const unsigned u = *(const unsigned*)(PRE + (size_t)row * PRE_W + PC_QKV + c);
      const float c0 = bflo(u), c1 = bfhi(u);
      const float2 w3 = *(const float2*)(gcw + (size_t)3 * 1536 + c);
      float acc0 = c0 * w3.x, acc1 = c1 * w3.y;
#pragma unroll
      for (int j = 0; j < 3; ++j) {
        const float2 h = *(const float2*)(ghist + ((size_t)b * 3 + j) * 1536 + c);
        const float2 w = *(const float2*)(gcw + (size_t)j * 1536 + c);
        acc0 += h.x * w.x; acc1 += h.y * w.y;
        if (j > 0) *(float2*)(o2 + (j - 1) * 1536 + c) = h;
      }
      *(float2*)(o2 + 2 * 1536 + c) = make_float2(c0, c1);
      val[i][0] = siluf_(acc0); val[i][1] = siluf_(acc1);
    }
    const float ssq = wave_sum(val[0][0] * val[0][0] + val[0][1] * val[0][1]);
    const float ssk = wave_sum(val[1][0] * val[1][0] + val[1][1] * val[1][1]);
    const float rq = rsqrtf(ssq + 1e-6f) * 0.08838834764831845f;
    const float rk = rsqrtf(ssk + 1e-6f);
    const unsigned uq = pack2(val[0][0] * rq, val[0][1] * rq);
    const unsigned uk = pack2(val[1][0] * rk, val[1][1] * rk);
    const unsigned uv = pack2(val[2][0], val[2][1]);
    const float qk = wave_sum(bflo(uq) * bflo(uk) + bfhi(uq) * bfhi(uk));
    *(unsigned*)(GQKV + (size_t)row * 1536 + 2 * tid) = uq;
    *(unsigned*)(GQKV + (size_t)row * 1536 + 512 + 2 * tid) = uk;
    *(unsigned*)(GQKV + (size_t)row * 1536 + 1024 + 2 * tid) = uv;
    if (lane == 0) {
      const int h = wave;
      const float g = -__expf(p.in[29][l * 4 + h]) *
                      softplusf_(bf2f(PRE[(size_t)row * PRE_W + PC_GA + h]) + p.in[28][l * 4 + h]);
      *(float4*)(GSC + ((size_t)row * 4 + h) * 4) =
          make_float4(__expf(g), sigmoidf_(bf2f(PRE[(size_t)row * PRE_W + PC_GB + h])), qk, 0.f);
    }
  }
}

__device__ __forceinline__ void prep_conv(const Params& p, int l, int item) {
  const int tid = otid(), lane = tid & 63, wave = tid >> 6;
  const int row0 = item * 8;
  if (row0 >= NTP) {
    for (int k = 0; k < 8; ++k) prep_conv_token(p, l, row0 + k, tid, lane, wave);
    return;
  }
  const bf16_t* PRE = (const bf16_t*)(p.ws + OFF_PRE);
  bf16_t* SXBC = (bf16_t*)(p.ws + OFF_SXBC);
  float* SDT = (float*)(p.ws + OFF_SDT);
  bf16_t* GQKV = (bf16_t*)(p.ws + OFF_GQKV);
  float* GSC = (float*)(p.ws + OFF_GSC);
  const int seq = row0 / LP, t0 = row0 - seq * LP;
  {
    const int c = tid * 4;
    const float* scw = p.in[21] + (size_t)l * 4 * 1024;
    const float4 w0 = *(const float4*)(scw + c), w1 = *(const float4*)(scw + 1024 + c);
    const float4 w2 = *(const float4*)(scw + 2048 + c), w3 = *(const float4*)(scw + 3072 + c);
    const float4 bs = *(const float4*)(p.in[22] + (size_t)l * 1024 + c);
    uint2 x[11];
#pragma unroll
    for (int j = 0; j < 11; ++j) {
      x[j] = make_uint2(0u, 0u);
      if (t0 - 3 + j >= 0) x[j] = *(const uint2*)(PRE + (size_t)(row0 - 3 + j) * PRE_W + PC_XBC + c);
    }
#pragma unroll
    for (int k = 0; k < 8; ++k) {
      const float a0 = bs.x + bflo(x[k].x) * w0.x + bflo(x[k + 1].x) * w1.x + bflo(x[k + 2].x) * w2.x + bflo(x[k + 3].x) * w3.x;
      const float a1 = bs.y + bfhi(x[k].x) * w0.y + bfhi(x[k + 1].x) * w1.y + bfhi(x[k + 2].x) * w2.y + bfhi(x[k + 3].x) * w3.y;
      const float a2 = bs.z + bflo(x[k].y) * w0.z + bflo(x[k + 1].y) * w1.z + bflo(x[k + 2].y) * w2.z + bflo(x[k + 3].y) * w3.z;
      const float a3 = bs.w + bfhi(x[k].y) * w0.w + bfhi(x[k + 1].y) * w1.w + bfhi(x[k + 2].y) * w2.w + bfhi(x[k + 3].y) * w3.w;
      uint2 o;
      o.x = pack2(siluf_(a0), siluf_(a1));
      o.y = pack2(siluf_(a2), siluf_(a3));
      *(uint2*)(SXBC + (size_t)(row0 + k) * 1024 + c) = o;
    }
    if (t0 + 8 == LP) {
#pragma unroll
      for (int j = 0; j < 3; ++j) {
        const uint2 u = x[8 + j];
        *(float4*)(p.out + O_P_SCONV + (((size_t)l * 8 + seq) * 3 + j) * 1024 + c) =
            make_float4(bflo(u.x), bfhi(u.x), bflo(u.y), bfhi(u.y));
      }
    }
    if (tid < 64) {
      const int tok = tid >> 3, h = tid & 7;
      const int row = row0 + tok;
      const float dtv = softplusf_(bf2f(PRE[(size_t)row * PRE_W + PC_DT + h]) + p.in[23][l * 8 + h]);
      const float a = -__expf(p.in[24][l * 8 + h]);
      SDT[(size_t)row * 16 + h * 2 + 0] = dtv;
      SDT[(size_t)row * 16 + h * 2 + 1] = __expf(dtv * a);
    }
  }
  {
    const float* gcw = p.in[27] + (size_t)l * 4 * 1536;
    unsigned x[3][11];
    float2 w[3][4];
#pragma unroll
    for (int i = 0; i < 3; ++i) {
      const int c = 2 * tid + 512 * i;
#pragma unroll
      for (int j = 0; j < 4; ++j) w[i][j] = *(const float2*)(gcw + (size_t)j * 1536 + c);
#pragma unroll
      for (int j = 0; j < 11; ++j) {
        x[i][j] = 0u;
        if (t0 - 3 + j >= 0) x[i][j] = *(const unsigned*)(PRE + (size_t)(row0 - 3 + j) * PRE_W + PC_QKV + c);
      }
    }
    if (t0 + 8 == LP) {
#pragma unroll
      for (int i = 0; i < 3; ++i)
#pragma unroll
        for (int j = 0; j < 3; ++j)
          *(float2*)(p.out + O_P_GCONV + (((size_t)l * 8 + seq) * 3 + j) * 1536 + 2 * tid + 512 * i) =
              make_float2(bflo(x[i][8 + j]), bfhi(x[i][8 + j]));
    }
    const float nega = -__expf(p.in[29][l * 4 + wave]);
    const float dtb = p.in[28][l * 4 + wave];
#pragma unroll
    for (int k = 0; k < 8; ++k) {
      float val[3][2];
#pragma unroll
      for (int i = 0; i < 3; ++i) {
        const float a0 = bflo(x[i][k]) * w[i][0].x + bflo(x[i][k + 1]) * w[i][1].x + bflo(x[i][k + 2]) * w[i][2].x + bflo(x[i][k + 3]) * w[i][3].x;
        const float a1 = bfhi(x[i][k]) * w[i][0].y + bfhi(x[i][k + 1]) * w[i][1].y + bfhi(x[i][k + 2]) * w[i][2].y + bfhi(x[i][k + 3]) * w[i][3].y;
        val[i][0] = siluf_(a0); val[i][1] = siluf_(a1);
      }
      const int row = row0 + k;
      const float ssq = wave_sum(val[0][0] * val[0][0] + val[0][1] * val[0][1]);
      const float ssk = wave_sum(val[1][0] * val[1][0] + val[1][1] * val[1][1]);
      const float rq = rsqrtf(ssq + 1e-6f) * 0.08838834764831845f;
      const float rk = rsqrtf(ssk + 1e-6f);
      const unsigned uq = pack2(val[0][0] * rq, val[0][1] * rq);
      const unsigned uk = pack2(val[1][0] * rk, val[1][1] * rk);
      const unsigned uv = pack2(val[2][0], val[2][1]);
      const float qk = wave_sum(bflo(uq) * bflo(uk) + bfhi(uq) * bfhi(uk));
      *(unsigned*)(GQKV + (size_t)row * 1536 + 2 * tid) = uq;
      *(unsigned*)(GQKV + (size_t)row * 1536 + 512 + 2 * tid) = uk;
      *(unsigned*)(GQKV + (size_t)row * 1536 + 1024 + 2 * tid) = uv;
      if (lane == 0) {
        const int h = wave;
        const float g = nega * softplusf_(bf2f(PRE[(size_t)row * PRE_W + PC_GA + h]) + dtb);
        *(float4*)(GSC + ((size_t)row * 4 + h) * 4) =
            make_float4(__expf(g), sigmoidf_(bf2f(PRE[(size_t)row * PRE_W + PC_GB + h])), qk, 0.f);
      }
    }
  }
}


__device__ __forceinline__ unsigned ho_ld(const unsigned* p) { return __hip_atomic_load(p, __ATOMIC_RELAXED, __HIP_MEMORY_SCOPE_AGENT); }
__device__ __forceinline__ void slab_publish(unsigned* flag) {
  asm volatile("s_waitcnt vmcnt(0)" ::: "memory");
  __syncthreads();
  if (threadIdx.x == 0) {
    __builtin_amdgcn_fence(__ATOMIC_RELEASE, "agent");
    asm volatile("s_waitcnt vmcnt(0)" ::: "memory");
    (void)__hip_atomic_fetch_add(flag, 1u, __ATOMIC_RELAXED, __HIP_MEMORY_SCOPE_AGENT);
  }
}
__device__ __forceinline__ void slab_wait(const unsigned* flag, unsigned expect) {
  if (threadIdx.x == 0) {
    unsigned sp = 0;
    while (ho_ld(flag) < expect) { __builtin_amdgcn_s_sleep(2); if (++sp > (1u << 20)) break; }
    __builtin_amdgcn_fence(__ATOMIC_ACQUIRE, "agent");
    asm volatile("s_waitcnt vmcnt(0)" ::: "memory");
  }
  __syncthreads();
}
constexpr int SLAB_CHUNKS = 43;
constexpr int SLAB_GUARD = 8;

using f32x2 = __attribute__((ext_vector_type(2))) float;
__device__ __forceinline__ f32x2 lo2(const f32x4& v) { return __builtin_shufflevector(v, v, 0, 1); }
__device__ __forceinline__ f32x2 hi2(const f32x4& v) { return __builtin_shufflevector(v, v, 2, 3); }
__device__ __forceinline__ f32x2 splat2(float x) { return (f32x2){x, x}; }

__device__ __forceinline__ void cvt8(const u32x4& u, float4& lo, float4& hi) {
  lo = make_float4(bflo(u.x), bfhi(u.x), bflo(u.y), bfhi(u.y));
  hi = make_float4(bflo(u.z), bfhi(u.z), bflo(u.w), bfhi(u.w));
}

#define SCAN_INTERLEAVE(nds, nvalu)                                   \
  _Pragma("unroll") for (int i_ = 0; i_ < (nds); ++i_) {               \
    __builtin_amdgcn_sched_group_barrier(0x100, 1, 0);                 \
    __builtin_amdgcn_sched_group_barrier(0x002, (nvalu), 0);           \
  }
struct RwP { f32x4 pw; u32x4 pb[3]; float4 psc; uint2 zn; };
struct SsP { u32x4 pb[3]; float2 psc; uint2 zn; };
struct GdP { u32x4 pb[3]; float4 psc; unsigned zn; };
struct RwRegs { f32x4 a[2], wr[2], w[2], b[2], k[2]; f32x4 sc; f32x2 v; };
__device__ __forceinline__ void rw_load(RwRegs& R, const float* vb, const float* sb, int t, int k0, int vrow0) {
  const float* vt = vb + t * 384 + k0;
#pragma unroll
  for (int q = 0; q < 2; ++q) {
    R.a[q] = *(const f32x4*)(vt + q * 4);
    R.wr[q] = *(const f32x4*)(vt + 128 + q * 4);
    R.w[q] = *(const f32x4*)(vt + 64 + q * 4);
    R.b[q] = *(const f32x4*)(vt + 192 + q * 4);
    R.k[q] = *(const f32x4*)(vt + 256 + q * 4);
  }
  R.v = *(const f32x2*)(vb + t * 384 + 320 + vrow0);
  R.sc = *(const f32x4*)(sb + t * 4);
}
__device__ __forceinline__ f32x2 rw_step(f32x2 (&S)[2][4], const RwRegs& R) {
  float sa[2], sy[2];
#pragma unroll
  for (int r = 0; r < 2; ++r) {
    f32x2 a0 = S[r][0] * lo2(R.a[0]);
    f32x2 a1 = S[r][1] * hi2(R.a[0]);
    f32x2 y0 = S[r][0] * lo2(R.wr[0]);
    f32x2 y1 = S[r][1] * hi2(R.wr[0]);
    a0 += S[r][2] * lo2(R.a[1]);
    a1 += S[r][3] * hi2(R.a[1]);
    y0 += S[r][2] * lo2(R.wr[1]);
    y1 += S[r][3] * hi2(R.wr[1]);
    a0 += a1; y0 += y1;
    sa[r] = a0.x + a0.y; sy[r] = y0.x + y0.y;
  }
  sa[0] = red8(sa[0]); sa[1] = red8(sa[1]); sy[0] = red8(sy[0]); sy[1] = red8(sy[1]);
  f32x2 yv;
#pragma unroll
  for (int r = 0; r < 2; ++r) {
    const float vr = r ? R.v.y : R.v.x;
    const f32x2 sa2 = splat2(sa[r]), vv2 = splat2(vr);
    S[r][0] = S[r][0] * lo2(R.w[0]) + (sa2 * lo2(R.b[0]) + vv2 * lo2(R.k[0]));
    S[r][1] = S[r][1] * hi2(R.w[0]) + (sa2 * hi2(R.b[0]) + vv2 * hi2(R.k[0]));
    S[r][2] = S[r][2] * lo2(R.w[1]) + (sa2 * lo2(R.b[1]) + vv2 * lo2(R.k[1]));
    S[r][3] = S[r][3] * hi2(R.w[1]) + (sa2 * hi2(R.b[1]) + vv2 * hi2(R.k[1]));
    const float y = sy[r] + sa[r] * R.sc.x + vr * R.sc.y;
    if (r) yv.y = y; else yv.x = y;
  }
  return yv;
}

__device__ __forceinline__ void scan_rwkv(const Params& p, int l, int seq, int h, char* smem, const unsigned* wflags, unsigned wexpect) {
  float* vec = (float*)smem;
  float* scb = vec + 2 * 16 * 384;
  float* yb = scb + 2 * 16 * 4;
  const int tid = otid(), lane = tid & 63, wave = tid >> 6;
  const int vrow0 = wave * 16 + (lane >> 3) * 2, part = lane & 7, k0 = part * 8;
  int T, row0; const float* st_in; float* st_out;
  if (seq < 8) { T = LP; row0 = seq * LP; st_in = nullptr; st_out = p.out + O_P_WKV + (((size_t)l * 8 + seq) * 8 + h) * 4096; }
  else { const int b = seq - 8; T = 1; row0 = NTP + b;
         st_in = p.in[2] + (((size_t)l * 128 + b) * 8 + h) * 4096;
         st_out = p.out + O_S_WKV + (((size_t)l * 128 + b) * 8 + h) * 4096; }
  f32x2 S[2][4];
  if (st_in) {
#pragma unroll
    for (int r = 0; r < 2; ++r)
#pragma unroll
      for (int q = 0; q < 2; ++q) {
        const f32x4 v = *(const f32x4*)(st_in + (vrow0 + r) * 64 + k0 + q * 4);
        S[r][2 * q] = lo2(v); S[r][2 * q + 1] = hi2(v);
      }
  } else {
#pragma unroll
    for (int r = 0; r < 2; ++r)
#pragma unroll
      for (int i = 0; i < 4; ++i) S[r][i] = splat2(0.f);
  }
  const float* RWW = (const float*)(p.ws + OFF_RWW);
  const bf16_t* RW5 = (const bf16_t*)(p.ws + OFF_RW5);
  const float* RWSC = (const float*)(p.ws + OFF_RWSC);
  const bf16_t* POST = (const bf16_t*)(p.ws + OFF_POST);
  bf16_t* BR = (bf16_t*)(p.out + O_YP);
  const int st_t = tid >> 4, st_j = tid & 15;
  const float4 gw = *(const float4*)(p.in[19] + (size_t)l * 512 + h * 64 + st_j * 4);
  const float4 gb = *(const float4*)(p.in[20] + (size_t)l * 512 + h * 64 + st_j * 4);
  const int nch = (T + 15) >> 4;
  uint2 zc = make_uint2(0, 0);

  const int tcl = (T >= 16) ? 1 : 0;
  const int oW = (row0 + st_t * tcl) * 512 + h * 64 + st_j * 4;
  const int oZ = (row0 + st_t * tcl) * POST_W + QC_RWZ + h * 64 + st_j * 4;
  const int oS = ((row0 + (tid & 15) * tcl) * 8 + h) * 4;
  int oB[3];
#pragma unroll
  for (int i = 0; i < 3; ++i) {
    const int idx = (tid + 256 * i < 640) ? tid + 256 * i : 0;
    const int arr = idx >> 7, rem = idx & 127, tt = rem >> 3, chn = rem & 7;
    oB[i] = ((row0 + tt * tcl) * 5 + arr) * 512 + h * 64 + chn * 8;
  }
  auto prefetch = [&](RwP& P, int c)
  {
    const int cc = c * 16;
    P.pw = *(const f32x4*)(RWW + oW + cc * 512);
    P.zn = *(const uint2*)(POST + oZ + cc * POST_W);
    P.pb[0] = *(const u32x4*)(RW5 + oB[0] + cc * 2560);
    P.pb[1] = *(const u32x4*)(RW5 + oB[1] + cc * 2560);
    if (tid < 128) P.pb[2] = *(const u32x4*)(RW5 + oB[2] + cc * 2560);
    if (tid < 16) P.psc = *(const float4*)(RWSC + oS + cc * 32);
  };
  int sB_[3];
#pragma unroll
  for (int i = 0; i < 3; ++i) {
    const int idx = (tid + 256 * i < 640) ? tid + 256 * i : 0;
    const int arr = idx >> 7, rem = idx & 127, tt = rem >> 3, chn = rem & 7;
    sB_[i] = tt * 384 + ((arr == 0) ? 0 : arr + 1) * 64 + chn * 8;
  }
  const int sW_ = st_t * 384 + 64 + st_j * 4;
  auto stage = [&](const RwP& P, int buf)
  {
    float* vb_ = vec + buf * 16 * 384;
    *(f32x4*)(vb_ + sW_) = P.pw;
    float4 lo, hi;
    cvt8(P.pb[0], lo, hi); *(float4*)(vb_ + sB_[0]) = lo; *(float4*)(vb_ + sB_[0] + 4) = hi;
    cvt8(P.pb[1], lo, hi); *(float4*)(vb_ + sB_[1]) = lo; *(float4*)(vb_ + sB_[1] + 4) = hi;
    if (tid < 128) { cvt8(P.pb[2], lo, hi); *(float4*)(vb_ + sB_[2]) = lo; *(float4*)(vb_ + sB_[2] + 4) = hi; }
    if (tid < 16) *(float4*)(scb + buf * 64 + tid * 4) = P.psc;
  };
  RwP P0{}, P1{};
  __syncthreads();
  prefetch(P0, 0);
  stage(P0, 0);
  zc = P0.zn;
  if (nch > 1) prefetch(P1, 1);
  __syncthreads();
  auto body = [&](int c, RwP& Pfree, const RwP& Pfull) {
    const int cur = c & 1;
    if (wexpect && T > 16 && (c + 2 == SLAB_CHUNKS - SLAB_GUARD || c + 2 == 2 * SLAB_CHUNKS - SLAB_GUARD))
      slab_wait(wflags + ((c + 2 == SLAB_CHUNKS - SLAB_GUARD) ? 0 : 16), wexpect);
    prefetch(Pfree, min(c + 2, nch - 1));
    const int nsteps = min(16, T - c * 16);
    const float* vb = vec + cur * 16 * 384;
    const float* sb = scb + cur * 64;
    RwRegs RA, RB;
    float* ydummy = yb + 16 * 64 + tid * 2;
    rw_load(RA, vb, sb, 0, k0, vrow0);
    for (int t = 0; t < nsteps; t += 2) {
      rw_load(RB, vb, sb, min(t + 1, 15), k0, vrow0);
      const f32x2 y0v = rw_step(S, RA);
      *(f32x2*)((part == 0) ? (yb + t * 64 + vrow0) : ydummy) = y0v;
      SCAN_INTERLEAVE(13, 4);
      if (t + 1 < nsteps) {
        rw_load(RA, vb, sb, min(t + 2, 15), k0, vrow0);
        const f32x2 y1v = rw_step(S, RB);
        *(f32x2*)((part == 0) ? (yb + (t + 1) * 64 + vrow0) : ydummy) = y1v;
        SCAN_INTERLEAVE(13, 4);
      }
    }
    __syncthreads();
    {
      const int t = st_t, c4 = st_j * 4;
      const bool valid = t < nsteps;
      const float4 y = *(const float4*)(yb + t * 64 + c4);
      float s = red16(y.x + y.y + y.z + y.w);
      const float mean = s * (1.f / 64.f);
      const float d0 = y.x - mean, d1 = y.y - mean, d2 = y.z - mean, d3 = y.w - mean;
      const float var = red16(d0 * d0 + d1 * d1 + d2 * d2 + d3 * d3) * (1.f / 64.f);
      const float rstd = rsqrtf(var + 64e-5f);
      if (valid) {
        const int row = row0 + c * 16 + t;
        const float rks = sb[t * 4 + 2];
        const float4 v4 = *(const float4*)(vb + t * 384 + 320 + c4);
        const float o0 = (d0 * rstd * gw.x + gb.x + rks * v4.x) * siluf_(bflo(zc.x));
        const float o1 = (d1 * rstd * gw.y + gb.y + rks * v4.y) * siluf_(bfhi(zc.x));
        const float o2 = (d2 * rstd * gw.z + gb.z + rks * v4.z) * siluf_(bflo(zc.y));
        const float o3 = (d3 * rstd * gw.w + gb.w + rks * v4.w) * siluf_(bfhi(zc.y));
        uint2 o; o.x = pack2(o0, o1); o.y = pack2(o2, o3);
        *(uint2*)(BR + (size_t)row * 1536 + h * 64 + c4) = o;
      }
    }
    if (c + 1 < nch) { stage(Pfull, cur ^ 1); zc = Pfull.zn; }
    __syncthreads();
  };
  for (int c = 0; c < nch; c += 2) {
    body(c, P0, P1);
    if (c + 1 < nch) body(c + 1, P1, P0);
  }
#pragma unroll
  for (int r = 0; r < 2; ++r)
#pragma unroll
    for (int q = 0; q < 2; ++q)
      *(f32x4*)(st_out + (vrow0 + r) * 64 + k0 + q * 4) =
          (f32x4){S[r][2 * q].x, S[r][2 * q].y, S[r][2 * q + 1].x, S[r][2 * q + 1].y};
}

struct SsRegs { f32x4 B[4], C[4]; f32x2 sc; f32x2 x; };
__device__ __forceinline__ void ss_load(SsRegs& R, const float* vb, const float* sb, int t, int n0, int prow0) {
  const float* vt = vb + t * 320;
#pragma unroll
  for (int q = 0; q < 4; ++q) {
    R.B[q] = *(const f32x4*)(vt + n0 + q * 4);
    R.C[q] = *(const f32x4*)(vt + 128 + n0 + q * 4);
  }
  R.x = *(const f32x2*)(vt + 256 + prow0);
  R.sc = *(const f32x2*)(sb + t * 2);
}
__device__ __forceinline__ f32x2 ss_step(f32x2 (&S)[2][8], const SsRegs& R) {
  const f32x2 dA2 = splat2(R.sc.y);
  f32x2 out;
#pragma unroll
  for (int r = 0; r < 2; ++r) {
    const f32x2 xdt2 = splat2((r ? R.x.y : R.x.x) * R.sc.x);
    f32x2 y0 = splat2(0.f), y1 = splat2(0.f);
#pragma unroll
    for (int q = 0; q < 4; ++q) {
      S[r][2 * q] = S[r][2 * q] * dA2 + xdt2 * lo2(R.B[q]);
      S[r][2 * q + 1] = S[r][2 * q + 1] * dA2 + xdt2 * hi2(R.B[q]);
      y0 += S[r][2 * q] * lo2(R.C[q]);
      y1 += S[r][2 * q + 1] * hi2(R.C[q]);
    }
    y0 += y1;
    const float y = red8(y0.x + y0.y);
    if (r) out.y = y; else out.x = y;
  }
  return out;
}

__device__ __forceinline__ void scan_ssm(const Params& p, int l, int seq, int h, char* smem, const unsigned* wflags, unsigned wexpect) {
  float* vec = (float*)smem;
  float* scb = vec + 2 * 16 * 320;
  float* yb = scb + 2 * 16 * 2;
  const int tid = otid(), lane = tid & 63, wave = tid >> 6;
  const int prow0 = wave * 16 + (lane >> 3) * 2, part = lane & 7, n0 = part * 16;
  const int g = h >> 2;
  int T, row0; const float* st_in; float* st_out;
  if (seq < 8) { T = LP; row0 = seq * LP; st_in = nullptr; st_out = p.out + O_P_SSM + (((size_t)l * 8 + seq) * 8 + h) * 8192; }
  else { const int b = seq - 8; T = 1; row0 = NTP + b;
         st_in = p.in[4] + (((size_t)l * 128 + b) * 8 + h) * 8192;
         st_out = p.out + O_S_SSM + (((size_t)l * 128 + b) * 8 + h) * 8192; }
  f32x2 S[2][8];
  if (st_in) {
#pragma unroll
    for (int r = 0; r < 2; ++r)
#pragma unroll
      for (int q = 0; q < 4; ++q) {
        const f32x4 v = *(const f32x4*)(st_in + (prow0 + r) * 128 + n0 + q * 4);
        S[r][2 * q] = lo2(v); S[r][2 * q + 1] = hi2(v);
      }
  } else {
#pragma unroll
    for (int r = 0; r < 2; ++r)
#pragma unroll
      for (int i = 0; i < 8; ++i) S[r][i] = splat2(0.f);
  }
  const bf16_t* SXBC = (const bf16_t*)(p.ws + OFF_SXBC);
  const float* SDT = (const float*)(p.ws + OFF_SDT);
  const bf16_t* POST = (const bf16_t*)(p.ws + OFF_POST);
  bf16_t* BR = (bf16_t*)(p.out + O_YP);
  float* STAT = (float*)(p.ws + OFF_STAT);
  const float dskip = p.in[25][l * 8 + h];
  const int nch = (T + 15) >> 4;
  uint2 zc = make_uint2(0, 0);
  const int st_t = tid >> 4, st_j = tid & 15;

  const int tcl = (T >= 16) ? 1 : 0;
  const int oZ = (row0 + st_t * tcl) * POST_W + QC_SSMZ + h * 64 + st_j * 4;
  const int oS = (row0 + (tid & 15) * tcl) * 16 + h * 2;
  int oB[3];
#pragma unroll
  for (int i = 0; i < 3; ++i) {
    const int idx = (tid + 256 * i < 640) ? tid + 256 * i : 0;
    const int tt = idx / 40, chn = idx - tt * 40;
    int col;
    if (chn < 16) col = 512 + g * 128 + chn * 8;
    else if (chn < 32) col = 768 + g * 128 + (chn - 16) * 8;
    else col = h * 64 + (chn - 32) * 8;
    oB[i] = (row0 + tt * tcl) * 1024 + col;
  }
  auto prefetch = [&](SsP& P, int c)
  {
    const int cc = c * 16;
    P.pb[0] = *(const u32x4*)(SXBC + oB[0] + cc * 1024);
    P.pb[1] = *(const u32x4*)(SXBC + oB[1] + cc * 1024);
    if (tid < 128) P.pb[2] = *(const u32x4*)(SXBC + oB[2] + cc * 1024);
    P.zn = *(const uint2*)(POST + oZ + cc * POST_W);
    if (tid < 16) P.psc = *(const float2*)(SDT + oS + cc * 16);
  };
  int sB_[3];
#pragma unroll
  for (int i = 0; i < 3; ++i) {
    const int idx = (tid + 256 * i < 640) ? tid + 256 * i : 0;
    const int tt = idx / 40, chn = idx - tt * 40;
    sB_[i] = tt * 320 + chn * 8;
  }
  auto stage = [&](const SsP& P, int buf)
  {
    float* vb_ = vec + buf * 16 * 320;
    float4 lo, hi;
    cvt8(P.pb[0], lo, hi); *(float4*)(vb_ + sB_[0]) = lo; *(float4*)(vb_ + sB_[0] + 4) = hi;
    cvt8(P.pb[1], lo, hi); *(float4*)(vb_ + sB_[1]) = lo; *(float4*)(vb_ + sB_[1] + 4) = hi;
    if (tid < 128) { cvt8(P.pb[2], lo, hi); *(float4*)(vb_ + sB_[2]) = lo; *(float4*)(vb_ + sB_[2] + 4) = hi; }
    if (tid < 16) *(float2*)(scb + buf * 32 + tid * 2) = P.psc;
  };
  SsP P0{}, P1{};
  __syncthreads();
  prefetch(P0, 0);
  stage(P0, 0);
  zc = P0.zn;
  if (nch > 1) prefetch(P1, 1);
  __syncthreads();
  auto body = [&](int c, SsP& Pfree, const SsP& Pfull) {
    const int cur = c & 1;
    if (wexpect && T > 16 && (c + 2 == SLAB_CHUNKS - SLAB_GUARD || c + 2 == 2 * SLAB_CHUNKS - SLAB_GUARD))
      slab_wait(wflags + ((c + 2 == SLAB_CHUNKS - SLAB_GUARD) ? 0 : 16), wexpect);
    prefetch(Pfree, min(c + 2, nch - 1));
    const int nsteps = min(16, T - c * 16);
    const float* vb = vec + cur * 16 * 320;
    const float* sb = scb + cur * 32;
    SsRegs RA, RB;
    float* ydummy = yb + 16 * 64 + tid * 2;
    ss_load(RA, vb, sb, 0, n0, prow0);
    for (int t = 0; t < nsteps; t += 2) {
      ss_load(RB, vb, sb, min(t + 1, 15), n0, prow0);
      const f32x2 y0v = ss_step(S, RA);
      *(f32x2*)((part == 0) ? (yb + t * 64 + prow0) : ydummy) = y0v;
      SCAN_INTERLEAVE(10, 5);
      if (t + 1 < nsteps) {
        ss_load(RA, vb, sb, min(t + 2, 15), n0, prow0);
        const f32x2 y1v = ss_step(S, RB);
        *(f32x2*)((part == 0) ? (yb + (t + 1) * 64 + prow0) : ydummy) = y1v;
        SCAN_INTERLEAVE(10, 5);
      }
    }
    __syncthreads();
    {
      const int t = st_t, c4 = st_j * 4;
      const bool valid = t < nsteps;
      const int row = row0 + c * 16 + (valid ? t : 0);
      const float4 y = *(const float4*)(yb + t * 64 + c4);
      const float4 x = *(const float4*)(vb + t * 320 + 256 + c4);
      const float g0 = (y.x + dskip * x.x) * siluf_(bflo(zc.x));
      const float g1 = (y.y + dskip * x.y) * siluf_(bfhi(zc.x));
      const float g2 = (y.z + dskip * x.z) * siluf_(bflo(zc.y));
      const float g3 = (y.w + dskip * x.w) * siluf_(bfhi(zc.y));
      const float ssq = red16(g0 * g0 + g1 * g1 + g2 * g2 + g3 * g3);
      if (valid) {
        uint2 o; o.x = pack2(g0, g1); o.y = pack2(g2, g3);
        *(uint2*)(BR + (size_t)row * 1536 + 512 + h * 64 + c4) = o;
        if (st_j == 0) STAT[(size_t)row * 32 + h] = ssq;
      }
    }
    if (c + 1 < nch) { stage(Pfull, cur ^ 1); zc = Pfull.zn; }
    __syncthreads();
  };
  for (int c = 0; c < nch; c += 2) {
    body(c, P0, P1);
    if (c + 1 < nch) body(c + 1, P1, P0);
  }
#pragma unroll
  for (int r = 0; r < 2; ++r)
#pragma unroll
    for (int q = 0; q < 4; ++q)
      *(f32x4*)(st_out + (prow0 + r) * 128 + n0 + q * 4) =
          (f32x4){S[r][2 * q].x, S[r][2 * q].y, S[r][2 * q + 1].x, S[r][2 * q + 1].y};
}

struct GdRegs { f32x4 q[4], k[4]; f32x4 sc; float v; };
__device__ __forceinline__ void gd_load(GdRegs& R, const float* vb, const float* sb, int t, int k0, int cl) {
  const float* vt = vb + t * 288;
#pragma unroll
  for (int q = 0; q < 4; ++q) {
    R.q[q] = *(const f32x4*)(vt + k0 + q * 4);
    R.k[q] = *(const f32x4*)(vt + 128 + k0 + q * 4);
  }
  R.v = vt[256 + cl];
  R.sc = *(const f32x4*)(sb + t * 4);
}
__device__ __forceinline__ float gd_step(f32x2 (&S)[8], const GdRegs& R) {
  f32x2 k0a = splat2(0.f), k1a = splat2(0.f), q0a = splat2(0.f), q1a = splat2(0.f);
#pragma unroll
  for (int q = 0; q < 4; ++q) {
    k0a += S[2 * q] * lo2(R.k[q]);
    k1a += S[2 * q + 1] * hi2(R.k[q]);
    q0a += S[2 * q] * lo2(R.q[q]);
    q1a += S[2 * q + 1] * hi2(R.q[q]);
  }
  k0a += k1a; q0a += q1a;
  const float dK = red8(k0a.x + k0a.y), dQ = red8(q0a.x + q0a.y);
  const float vn = R.sc.y * (R.v - R.sc.x * dK);
  const float o = R.sc.x * dQ + R.sc.z * vn;
  const f32x2 al2 = splat2(R.sc.x), vn2 = splat2(vn);
#pragma unroll
  for (int q = 0; q < 4; ++q) {
    S[2 * q] = S[2 * q] * al2 + lo2(R.k[q]) * vn2;
    S[2 * q + 1] = S[2 * q + 1] * al2 + hi2(R.k[q]) * vn2;
  }
  return o;
}

__device__ __forceinline__ void scan_gdn(const Params& p, int l, int seq, int h, int qt, char* smem, const unsigned* wflags, unsigned wexpect) {
  float* vec = (float*)smem;
  float* scb = vec + 2 * 16 * 288;
  float* yb = scb + 2 * 16 * 4;
  const int tid = otid(), lane = tid & 63, wave = tid >> 6;
  const int cl = wave * 8 + (lane >> 3), part = lane & 7, k0 = part * 16;
  const int col = qt * 32 + cl;
  int T, row0; const float* st_in; float* st_out;
  if (seq < 8) { T = LP; row0 = seq * LP; st_in = nullptr; st_out = p.out + O_P_GDN + (((size_t)l * 8 + seq) * 4 + h) * 16384; }
  else { const int b = seq - 8; T = 1; row0 = NTP + b;
         st_in = p.in[6] + (((size_t)l * 128 + b) * 4 + h) * 16384;
         st_out = p.out + O_S_GDN + (((size_t)l * 128 + b) * 4 + h) * 16384; }
  f32x2 S[8];
  if (st_in) {
#pragma unroll
    for (int i = 0; i < 8; ++i) {
      S[i].x = st_in[(size_t)(k0 + 2 * i) * 128 + col];
      S[i].y = st_in[(size_t)(k0 + 2 * i + 1) * 128 + col];
    }
  } else {
#pragma unroll
    for (int i = 0; i < 8; ++i) S[i] = splat2(0.f);
  }
  const bf16_t* GQKV = (const bf16_t*)(p.ws + OFF_GQKV);
  const float* GSC = (const float*)(p.ws + OFF_GSC);
  const bf16_t* POST = (const bf16_t*)(p.ws + OFF_POST);
  bf16_t* BR = (bf16_t*)(p.out + O_YP);
  float* STAT = (float*)(p.ws + OFF_STAT);
  const int nch = (T + 15) >> 4;
  unsigned zc = 0;
  const int st_t = tid >> 4, st_j = tid & 15;

  const int tcl = (T >= 16) ? 1 : 0;
  const int oZ = (row0 + st_t * tcl) * POST_W + QC_GDNZ + h * 128 + qt * 32 + st_j * 2;
  const int oS = ((row0 + (tid & 15) * tcl) * 4 + h) * 4;
  int oB[3];
#pragma unroll
  for (int i = 0; i < 3; ++i) {
    const int idx = (tid + 256 * i < 576) ? tid + 256 * i : 0;
    const int tt = idx / 36, chn = idx - tt * 36;
    int cc_;
    if (chn < 16) cc_ = h * 128 + chn * 8;
    else if (chn < 32) cc_ = 512 + h * 128 + (chn - 16) * 8;
    else cc_ = 1024 + h * 128 + qt * 32 + (chn - 32) * 8;
    oB[i] = (row0 + tt * tcl) * 1536 + cc_;
  }
  auto prefetch = [&](GdP& P, int c)
  {
    const int cc = c * 16;
    P.pb[0] = *(const u32x4*)(GQKV + oB[0] + cc * 1536);
    P.pb[1] = *(const u32x4*)(GQKV + oB[1] + cc * 1536);
    if (tid < 64) P.pb[2] = *(const u32x4*)(GQKV + oB[2] + cc * 1536);
    P.zn = *(const unsigned*)(POST + oZ + cc * POST_W);
    if (tid < 16) P.psc = *(const float4*)(GSC + oS + cc * 16);
  };
  int sB_[3];
#pragma unroll
  for (int i = 0; i < 3; ++i) {
    const int idx = (tid + 256 * i < 576) ? tid + 256 * i : 0;
    const int tt = idx / 36, chn = idx - tt * 36;
    sB_[i] = tt * 288 + chn * 8;
  }
  auto stage = [&](const GdP& P, int buf)
  {
    float* vb_ = vec + buf * 16 * 288;
    float4 lo, hi;
    cvt8(P.pb[0], lo, hi); *(float4*)(vb_ + sB_[0]) = lo; *(float4*)(vb_ + sB_[0] + 4) = hi;
    cvt8(P.pb[1], lo, hi); *(float4*)(vb_ + sB_[1]) = lo; *(float4*)(vb_ + sB_[1] + 4) = hi;
    if (tid < 64) { cvt8(P.pb[2], lo, hi); *(float4*)(vb_ + sB_[2]) = lo; *(float4*)(vb_ + sB_[2] + 4) = hi; }
    if (tid < 16) *(float4*)(scb + buf * 64 + tid * 4) = P.psc;
  };
  GdP P0{}, P1{};
  __syncthreads();
  prefetch(P0, 0);
  stage(P0, 0);
  zc = P0.zn;
  if (nch > 1) prefetch(P1, 1);
  __syncthreads();
  auto body = [&](int c, GdP& Pfree, const GdP& Pfull) {
    const int cur = c & 1;
    if (wexpect && T > 16 && (c + 2 == SLAB_CHUNKS - SLAB_GUARD || c + 2 == 2 * SLAB_CHUNKS - SLAB_GUARD))
      slab_wait(wflags + ((c + 2 == SLAB_CHUNKS - SLAB_GUARD) ? 0 : 16), wexpect);
    prefetch(Pfree, min(c + 2, nch - 1));
    const int nsteps = min(16, T - c * 16);
    const float* vb = vec + cur * 16 * 288;
    const float* sb = scb + cur * 64;
    GdRegs RA, RB;
    float* ydummy = yb + 16 * 32 + tid;
    gd_load(RA, vb, sb, 0, k0, cl);
    for (int t = 0; t < nsteps; t += 2) {
      gd_load(RB, vb, sb, min(t + 1, 15), k0, cl);
      const float o0v = gd_step(S, RA);
      *((part == 0) ? (yb + t * 32 + cl) : ydummy) = o0v;
      SCAN_INTERLEAVE(10, 4);
      if (t + 1 < nsteps) {
        gd_load(RA, vb, sb, min(t + 2, 15), k0, cl);
        const float o1v = gd_step(S, RB);
        *((part == 0) ? (yb + (t + 1) * 32 + cl) : ydummy) = o1v;
        SCAN_INTERLEAVE(10, 4);
      }
    }
    __syncthreads();
    {
      const int t = st_t, c2 = st_j * 2;
      const bool valid = t < nsteps;
      const int row = row0 + c * 16 + (valid ? t : 0);
      const float2 o = *(const float2*)(yb + t * 32 + c2);
      const float ssq = red16(o.x * o.x + o.y * o.y);
      if (valid) {
        *(unsigned*)(BR + (size_t)row * 1536 + 1024 + h * 128 + qt * 32 + c2) =
            pack2(o.x * siluf_(bflo(zc)), o.y * siluf_(bfhi(zc)));
        if (st_j == 0) STAT[(size_t)row * 32 + 16 + h * 4 + qt] = ssq;
      }
    }
    if (c + 1 < nch) { stage(Pfull, cur ^ 1); zc = Pfull.zn; }
    __syncthreads();
  };
  for (int c = 0; c < nch; c += 2) {
    body(c, P0, P1);
    if (c + 1 < nch) body(c + 1, P1, P0);
  }
#pragma unroll
  for (int i = 0; i < 8; ++i) {
    st_out[(size_t)(k0 + 2 * i) * 128 + col] = S[i].x;
    st_out[(size_t)(k0 + 2 * i + 1) * 128 + col] = S[i].y;
  }
}

__device__ __forceinline__ void scan_item(const Params& p, int l, int idx, bool is_long, char* smem, const unsigned* wflags, unsigned wexpect) {
  const int ns = is_long ? 8 : 128;
  const int sbase = is_long ? 0 : 8;
  const int n_rw = ns * 8, n_ss = ns * 8;
  if (idx < n_rw) { scan_rwkv(p, l, sbase + idx / 8, idx % 8, smem, wflags, 0u); return; }
  idx -= n_rw;
  if (idx < n_ss) { scan_ssm(p, l, sbase + idx / 8, idx % 8, smem, wflags, wexpect); return; }
  idx -= n_ss;
  { const int s = idx / 16, r = idx % 16; scan_gdn(p, l, sbase + s, r >> 2, r & 3, smem, wflags, wexpect); }
}

__device__ __forceinline__ void prep_item(const Params& p, int l, bool producer, int slab, int i, char* smem) {
  bool is_rw; int item;
  if (!producer) {
    if (i < 1040) { is_rw = true; item = i; }
    else {
      const int q = i - 1040;
      is_rw = false;
      if (q < 688) { const int b = q / 86, j = q - b * 86; item = b * 258 + j; }
      else item = 2064 + (q - 688);
    }
  } else {
    const int b = i / 86, j = i - b * 86;
    is_rw = false; item = b * 258 + slab * 86 + j;
  }
  if (is_rw) prep_rwkv(p, l, item, smem); else prep_conv(p, l, item);
}

__device__ __forceinline__ void phase_prep_scan(const Params& p, int l, bool is_scan, char* smem) {
  const int G = gridDim.x, bid = blockIdx.x;
  const int nlong = 256, nshort = 4096;
  const bool split = (G >= nlong + 64);
  const bool producer = split && bid >= nlong;
  unsigned* flags = (unsigned*)(p.ws + OFF_FLAGS) + l * 32;
  const unsigned wexpect = split ? (unsigned)(G - nlong) : 0u;
  const int nseg = is_scan ? 4 : (split ? 1 : 3);
  for (int seg = 0; seg < nseg; ++seg) {
    int kind, slab = 0, first, limit, stride;
    if (!is_scan) {
      kind = 0; slab = seg; first = bid; stride = G; limit = (seg == 0) ? (1040 + 688 + 16) : 688;
    } else if (seg == 0 || seg == 2) {
      kind = 0; slab = (seg == 0) ? 1 : 2; limit = 688;
      if (producer) { first = bid - nlong; stride = G - nlong; } else { first = limit; stride = 1; }
    } else if (seg == 1) {
      kind = 1;
      if (split) {
        if (bid < nlong) { first = bid; stride = G; limit = nlong; }
        else { first = bid; stride = G - nlong; limit = nlong + nshort; }
      } else { first = bid; stride = G; limit = nlong + nshort; }
    } else {
      kind = 2;
      const int n_conv = (NPAD / 64) * 16;
      limit = (l + 1 < DEPTH) ? n_conv : 0;
      if (split) { first = producer ? bid - nlong : limit; stride = producer ? G - nlong : 1; }
      else { first = bid; stride = G; }
      __syncthreads();
    }
    for (int i = first; i < limit; i += stride) {
      if (kind == 0) {
        prep_item(p, l, is_scan || seg > 0, slab, i, smem);
      } else if (kind == 1) {
        const bool is_long = i < nlong;
        scan_item(p, l, is_long ? i : i - nlong, is_long, smem, flags, is_long ? wexpect : 0u);
      } else {
        const int nt = i >> 4, kt = i & 15;
        convert_tile<true>(p.in[10] + (size_t)(l + 1) * 1024 * DPROJ, DPROJ, nt * 64, kt * 64,
                           (bf16_t*)(p.ws + OFF_WIN), 1024, smem);
      }
    }
    if (is_scan && kind == 0 && producer) slab_publish(flags + (slab - 1) * 16);
  }
}

__device__ __forceinline__ void phase_post(const Params& p, int l) {
  const int tid = otid(), lane = tid & 63, wave = tid >> 6;
  bf16_t* BR = (bf16_t*)(p.out + O_YP);
  const float* STAT = (const float*)(p.ws + OFF_STAT);
  const float* snw = p.in[26] + (size_t)l * 512;
  const float* gnw = p.in[30] + (size_t)l * 128;
  for (int it = blockIdx.x; it < NT / 4; it += gridDim.x) {
    const int row = it * 4 + wave;
    float rs; const float* nw;
    if (lane < 32) {
      const int g = lane >> 4;
      const float4 a = *(const float4*)(STAT + (size_t)row * 32 + g * 4);
      const float s = (a.x + a.y) + (a.z + a.w);
      rs = rsqrtf(s * (1.f / 256.f) + 1e-5f);
      nw = snw + lane * 16;
    } else {
      const int hh = (lane - 32) >> 3;
      const float4 a = *(const float4*)(STAT + (size_t)row * 32 + 16 + hh * 4);
      const float s = (a.x + a.y) + (a.z + a.w);
      rs = rsqrtf(s * (1.f / 128.f) + 1e-6f);
      nw = gnw + ((lane - 32) & 7) * 16;
    }
    bf16_t* ptr = BR + (size_t)row * 1536 + 512 + lane * 16;
#pragma unroll
    for (int q = 0; q < 2; ++q) {
      uint4 u = *(const uint4*)(ptr + q * 8);
      const float4 w0 = *(const float4*)(nw + q * 8);
      const float4 w1 = *(const float4*)(nw + q * 8 + 4);
      u.x = pack2(bflo(u.x) * rs * w0.x, bfhi(u.x) * rs * w0.y);
      u.y = pack2(bflo(u.y) * rs * w0.z, bfhi(u.y) * rs * w0.w);
      u.z = pack2(bflo(u.z) * rs * w1.x, bfhi(u.z) * rs * w1.y);
      u.w = pack2(bflo(u.w) * rs * w1.z, bfhi(u.w) * rs * w1.w);
      *(uint4*)(ptr + q * 8) = u;
    }
  }
}

__device__ __forceinline__ void phase_gemm_merge(const Params& p, char* smem) {
  const bf16_t* BR = (const bf16_t*)(p.out + O_YP);
  const bf16_t* W = (const bf16_t*)(p.ws + OFF_WBR);
  const bf16_t* POST = (const bf16_t*)(p.ws + OFF_POST);
  bf16_t* MG = (bf16_t*)(p.ws + OFF_MERGED);
  const int tid_ = otid(); const int lane = tid_ & 63, wave = tid_ >> 6, wm = wave >> 1, wn = wave & 1;
  const int MT = NT / 128, NTn = 8;
  const int iters = tile_iters(MT, NTn);
  for (int it = 0; it < iters; ++it) {
    int mt, nt;
    if (!tile_at(it, MT, NTn, mt, nt)) break;
    f32x4 outv[4][4];
#pragma unroll
    for (int i = 0; i < 4; ++i)
#pragma unroll
      for (int j = 0; j < 4; ++j) outv[i][j] = (f32x4){0.f, 0.f, 0.f, 0.f};
    for (int b = 0; b < 3; ++b) {
      f32x4 acc[4][4];
#pragma unroll
      for (int i = 0; i < 4; ++i)
#pragma unroll
        for (int j = 0; j < 4; ++j) acc[i][j] = (f32x4){0.f, 0.f, 0.f, 0.f};
      gemm_core<false>(BR + (size_t)mt * 128 * 1536 + b * 512, 1536, W + ((size_t)b * 1024 + nt * 128) * 512, 512, 512, acc, smem);
#pragma unroll
      for (int i = 0; i < 4; ++i) {
        const int m = mt * 128 + wm * 64 + i * 16 + (lane & 15);
#pragma unroll
        for (int j = 0; j < 4; ++j) {
          const int n = nt * 128 + wn * 64 + j * 16 + (lane >> 4) * 4;
          const uint2 gz = *(const uint2*)(POST + (size_t)m * POST_W + QC_GATE + b * 1024 + n);
          outv[i][j][0] += sigmoidf_(bflo(gz.x)) * acc[i][j][0];
          outv[i][j][1] += sigmoidf_(bfhi(gz.x)) * acc[i][j][1];
          outv[i][j][2] += sigmoidf_(bflo(gz.y)) * acc[i][j][2];
          outv[i][j][3] += sigmoidf_(bfhi(gz.y)) * acc[i][j][3];
        }
      }
    }
#pragma unroll
    for (int i = 0; i < 4; ++i) {
      const int m = mt * 128 + wm * 64 + i * 16 + (lane & 15);
#pragma unroll
      for (int j = 0; j < 4; ++j) {
        const int n = nt * 128 + wn * 64 + j * 16 + (lane >> 4) * 4;
        uint2 o;
        o.x = pack2(outv[i][j][0], outv[i][j][1]);
        o.y = pack2(outv[i][j][2], outv[i][j][3]);
        *(uint2*)(MG + (size_t)m * 1024 + n) = o;
      }
    }
  }
}

__device__ __forceinline__ void phase_gemm_out(const Params& p, char* smem) {
  const bf16_t* MG = (const bf16_t*)(p.ws + OFF_MERGED);
  const bf16_t* W = (const bf16_t*)(p.ws + OFF_WOUT);
  float* X = (float*)(p.ws + OFF_X);
  const int tid_ = otid(); const int lane = tid_ & 63, wave = tid_ >> 6, wm = wave >> 1, wn = wave & 1;
  const int MT = NT / 128, NTn = 8;
  const int iters = tile_iters(MT, NTn);
  for (int it = 0; it < iters; ++it) {
    int mt, nt;
    if (!tile_at(it, MT, NTn, mt, nt)) break;
    f32x4 acc[4][4];
#pragma unroll
    for (int i = 0; i < 4; ++i)
#pragma unroll
      for (int j = 0; j < 4; ++j) acc[i][j] = (f32x4){0.f, 0.f, 0.f, 0.f};
    gemm_core<true>(MG + (size_t)mt * 128 * 1024, 1024, W + (size_t)nt * 128 * 1024, 1024, 1024, acc, smem);
#pragma unroll
    for (int i = 0; i < 4; ++i) {
      const int m = mt * 128 + wm * 64 + i * 16 + (lane & 15);
#pragma unroll
      for (int j = 0; j < 4; ++j) {
        const int n = nt * 128 + wn * 64 + j * 16 + (lane >> 4) * 4;
        float4* xp = (float4*)(X + (size_t)m * 1024 + n);
        float4 x = *xp;
        x.x += acc[i][j][0]; x.y += acc[i][j][1]; x.z += acc[i][j][2]; x.w += acc[i][j][3];
        *xp = x;
      }
    }
  }
}

__device__ __forceinline__ void phase_final(const Params& p) {
  const int tid = otid(), lane = tid & 63, wave = tid >> 6;
  const float* X = (const float*)(p.ws + OFF_X);
  const float4* nw = (const float4*)p.in[35];
  for (int it = blockIdx.x; it < NT / 4; it += gridDim.x) {
    const int row = it * 4 + wave;
    float* dst;
    if (row < NTP) {
      const int b = row / LP, t = row - b * LP;
      if (t < 16) continue;
      dst = p.out + O_YP + ((size_t)b * 2048 + (t - 16)) * 1024;
    } else {
      dst = p.out + O_YS + (size_t)(row - NTP) * 1024;
    }
    const float4* src = (const float4*)(X + (size_t)row * 1024);
    float4 v[4];
    float ss = 0.f;
#pragma unroll
    for (int i = 0; i < 4; ++i) {
      v[i] = src[lane + 64 * i];
      ss += v[i].x * v[i].x + v[i].y * v[i].y + v[i].z * v[i].z + v[i].w * v[i].w;
    }
    ss = wave_sum(ss);
    const float rs = rsqrtf(ss * (1.f / 1024.f) + 1e-6f);
#pragma unroll
    for (int i = 0; i < 4; ++i) {
      const float4 w = nw[lane + 64 * i];
      ((float4*)dst)[lane + 64 * i] = make_float4(v[i].x * rs * w.x, v[i].y * rs * w.y, v[i].z * rs * w.z, v[i].w * rs * w.w);
    }
  }
}

#define XB_TMO      128
#define XB_XCNT(j)  (256  + 64 * (j))
#define XB_XSUB(j)  (1280 + 64 * (j))
#define XB_XGEN(j)  (2304 + 64 * (j))
#define XB_TOP      3328
#define XB_TOPGEN   3392
#define XCD_BAR_WORDS 3456
#define XB_SPIN_CAP (1u << 18)
#define LAS __attribute__((address_space(3)))

__device__ __forceinline__ unsigned xb_ld(unsigned* p)              { return __hip_atomic_load(p, __ATOMIC_RELAXED, __HIP_MEMORY_SCOPE_AGENT); }
__device__ __forceinline__ unsigned xb_add(unsigned* p, unsigned v) { return __hip_atomic_fetch_add(p, v, __ATOMIC_RELAXED, __HIP_MEMORY_SCOPE_AGENT); }
__device__ __forceinline__ unsigned xb_xcc_id() { return (unsigned)__builtin_amdgcn_s_getreg((3 << 11) | 20) & 0xFu; }
#define XB_SPIN(cond, bar) do { unsigned _sp = 0; while (cond) { __builtin_amdgcn_s_sleep(1); \
    if ((++_sp & 255u) == 0u) { if (xb_ld(&(bar)[XB_TMO])) break; if (_sp > XB_SPIN_CAP) { atomicAdd(&(bar)[XB_TMO], 1u); break; } } } } while (0)

struct XcdBarrier {
    unsigned* bar; unsigned x;
    volatile LAS unsigned* st;
};

__device__ __forceinline__ XcdBarrier xcd_barrier_post(unsigned* bar, volatile LAS unsigned* st) {
    XcdBarrier b; b.bar = bar; b.x = xb_xcc_id(); b.st = st;
    if (threadIdx.x == 0) (void)xb_add(&bar[XB_XCNT(b.x)], 1u);
    return b;
}
__device__ __forceinline__ void xcd_barrier_complete(unsigned* bar, unsigned x, unsigned& nloc, unsigned& nx) {
    const unsigned G = gridDim.x * gridDim.y * gridDim.z;
    unsigned sum, cnt, mine, sp = 0u;
    for (;;) {
        sum = 0u; cnt = 0u; mine = 0u;
#pragma unroll
        for (unsigned j = 0; j < 16; ++j) { const unsigned c = xb_ld(&bar[XB_XCNT(j)]); sum += c; cnt += (c > 0u) ? 1u : 0u; mine = (j == x) ? c : mine; }
        if (sum == G) break;
        __builtin_amdgcn_s_sleep(1);
        if ((++sp & 255u) == 0u) { if (xb_ld(&bar[XB_TMO])) break; if (sp > XB_SPIN_CAP) { atomicAdd(&bar[XB_TMO], 1u); break; } }
    }
    nloc = mine > 0u ? mine : 1u; nx = cnt > 0u ? cnt : 1u;
}

__device__ __forceinline__ void xcd_barrier(const XcdBarrier& b) {
    asm volatile("s_waitcnt vmcnt(0)" ::: "memory");
    __syncthreads();
    if (threadIdx.x == 0) {
        unsigned* bar = b.bar;
        __builtin_amdgcn_s_waitcnt(0);
        unsigned nloc = b.st[0], nx = b.st[1];
        if (nloc == 0u) { xcd_barrier_complete(bar, b.x, nloc, nx); b.st[0] = nloc; b.st[1] = nx; }
        const unsigned old = xb_add(&bar[XB_XSUB(b.x)], 1u);
        const unsigned gen = old / nloc;
        if (old + 1u == (gen + 1u) * nloc) {
            __builtin_amdgcn_fence(__ATOMIC_RELEASE, "agent");
            asm volatile("s_waitcnt vmcnt(0)" ::: "memory");
            const unsigned og = xb_add(&bar[XB_TOP], 1u);
            const unsigned tg = og / nx;
            if (og + 1u == (tg + 1u) * nx) xb_add(&bar[XB_TOPGEN], 1u);
            else XB_SPIN(xb_ld(&bar[XB_TOPGEN]) == tg, bar);
            __builtin_amdgcn_fence(__ATOMIC_ACQUIRE, "agent");
            xb_add(&bar[XB_XGEN(b.x)], 1u);
            asm volatile("s_waitcnt vmcnt(0)" ::: "memory");
        } else {
            XB_SPIN(xb_ld(&bar[XB_XGEN(b.x)]) == gen, bar);
            __builtin_amdgcn_fence(__ATOMIC_ACQUIRE, "agent");
            asm volatile("s_waitcnt vmcnt(0)" ::: "memory");
        }
    }
    __syncthreads();
}


constexpr int PH_PER_LAYER = 7;
constexpr int N_PHASES = DEPTH * PH_PER_LAYER + 1;

__global__ void __launch_bounds__(256, 2) mega_kernel(Params p, int ph_begin, int ph_end) {
  __shared__ __attribute__((aligned(16))) char smem[SMEM_BYTES];
  __shared__ uint4 xb_words;
  if (threadIdx.x == 0) xb_words = make_uint4(0u, 0u, 0u, 0u);
  __syncthreads();
  const XcdBarrier xb = xcd_barrier_post((unsigned*)(p.ws + OFF_BAR), (volatile LAS unsigned*)&xb_words);
  for (int ph = ph_begin; ph < ph_end; ++ph) {
    if (ph == N_PHASES - 1) {
      phase_final(p);
    } else {
      const int l = ph / PH_PER_LAYER, k = ph - l * PH_PER_LAYER;
#ifdef DOUBLE_MASK
      const int nrep = ((DOUBLE_MASK >> k) & 1) ? 2 : 1;
      for (int rep = 0; rep < nrep; ++rep)
#endif
#ifndef PHMASK
#define PHMASK 0x7f
#endif
      switch (k) {
        case 0: if (PHMASK & 1) phase_norm_convert(p, l, smem); break;
        case 1: if (PHMASK & 2) phase_gemm_in(p, smem); break;
        case 2:
        case 3: if (PHMASK & 12) phase_prep_scan(p, l, k == 3, smem); break;
        case 4: if (PHMASK & 16) phase_post(p, l); break;
        case 5: if (PHMASK & 32) phase_gemm_merge(p, smem); break;
        default: if (PHMASK & 64) phase_gemm_out(p, smem); break;
      }
    }
    if (ph + 1 < ph_end) {
      if (ph == ph_begin) cg::this_grid().sync();
      else xcd_barrier(xb);
    }
  }
}

extern "C" void kernel_launch(void* const* d_in, const int* in_sizes, int n_in, void* d_out, int out_size, void* d_ws,
                              size_t ws_size, hipStream_t stream) {
  if (n_in < 36 || ws_size < WS_NEED || (size_t)out_size < O_TOTAL) {
    fprintf(stderr, "kernel_launch: unexpected sizes n_in=%d ws=%zu need=%zu out=%d\n", n_in, ws_size, WS_NEED, out_size);
    return;
  }
  static int grid_blocks = 0;
  if (!grid_blocks) {
    int dev = 0, cus = 0, per_cu = 0;
    hipGetDevice(&dev);
    hipDeviceGetAttribute(&cus, hipDeviceAttributeMultiprocessorCount, dev);
    hipOccupancyMaxActiveBlocksPerMultiprocessor(&per_cu, mega_kernel, 256, 0);
    if (per_cu > 2) per_cu = 2;
    if (per_cu < 1) per_cu = 1;
    grid_blocks = cus * per_cu;
  }
  Params p{};
  for (int i = 0; i < 36; ++i) p.in[i] = (const float*)d_in[i];
  p.out = (float*)d_out;
  p.ws = (char*)d_ws;
  (void)hipMemsetAsync((char*)d_ws + OFF_BAR, 0, 16384 + 1024, stream);
#if MULTI_LAUNCH
  for (int ph = 0; ph < N_PHASES; ++ph) {
    hipLaunchKernelGGL(mega_kernel, dim3(grid_blocks), dim3(256), 0, stream, p, ph, ph + 1);
  }
#else
  int b = 0, e = N_PHASES;
  void* args[] = {&p, &b, &e};
  hipError_t err = hipLaunchCooperativeKernel((void*)mega_kernel, dim3(grid_blocks), dim3(256), args, 0, stream);
  if (err != hipSuccess) fprintf(stderr, "cooperative launch failed: %s (grid %d)\n", hipGetErrorString(err), grid_blocks);
#endif
}
```
